# Optimizing an MI355X kernel written in HIP

```python
import jax, jax.numpy as jnp
from jax import lax
import numpy as np

D_MODEL = 4096
BATCH = 4
SEQ = 2048
DEPTH = 1

HEAD_DIM = 128
N_HEADS = D_MODEL // HEAD_DIM
N_MOBA = N_HEADS // 2
N_FOX = N_HEADS - N_MOBA
D_MOBA = N_MOBA * HEAD_DIM
D_FOX = N_FOX * HEAD_DIM
D_IN = 3 * D_MOBA + 3 * D_FOX + N_FOX
MOBA_BLOCK = 256
MOBA_TOPK = 3
MOBA_QCHUNK = 16
FOX_QBLOCK = 128
PEER_HEADS = 8
PEER_NKEYS = 128
PEER_EXPERTS = PEER_NKEYS * PEER_NKEYS
PEER_TOPK = 16
PEER_DKEY = 256
PEER_HALF = PEER_DKEY // 2
PEER_TCHUNK = 128
N_MOD = 6
NORM_EPS = 1e-6
NEG_INF = -1e30

kernel_name = "hymba_moba_fox_peer_adaln"


def rms_norm(x, g):
    xf = x.astype(jnp.float32)
    y = xf * lax.rsqrt(jnp.mean(xf * xf, axis=-1, keepdims=True) + NORM_EPS)
    return (y * g.astype(jnp.float32)).astype(x.dtype)


def modulate(h, shift, scale):
    return h * (1 + scale[:, None, :]) + shift[:, None, :]


def split_heads(t, n):
    b, s, _ = t.shape
    return t.reshape(b, s, n, HEAD_DIM).transpose(0, 2, 1, 3)


def merge_heads(t):
    b, h, s, d = t.shape
    return t.transpose(0, 2, 1, 3).reshape(b, s, h * d)


def alibi_slopes(n):
    return 2.0 ** (-8.0 * jnp.arange(1, n + 1, dtype=jnp.float32) / n)


def moba_attention(q, k, v, slopes):
    B, H, S, hd = q.shape
    nb = -(-S // MOBA_BLOCK)
    sp = nb * MOBA_BLOCK
    pad = ((0, 0), (0, 0), (0, sp - S), (0, 0))
    kp = jnp.pad(k, pad)
    vp = jnp.pad(v, pad)
    counts = np.minimum(MOBA_BLOCK, S - np.arange(nb) * MOBA_BLOCK).astype(np.float32)
    kmean = kp.reshape(B, H, nb, MOBA_BLOCK, hd).astype(jnp.float32).sum(3) / counts[:, None]
    qblk = jnp.arange(S) // MOBA_BLOCK
    gate = jnp.einsum('bhsd,bhnd->bhsn', q.astype(jnp.float32), kmean)
    past = jnp.arange(nb)[None, :] < qblk[:, None]
    gate = jnp.where(past, gate, NEG_INF)
    ksel = min(MOBA_TOPK, nb)
    _, sel = lax.top_k(gate, ksel)
    sel_valid = sel < qblk[:, None]
    scale = HEAD_DIM ** -0.5
    offs = jnp.arange(MOBA_BLOCK)
    bidx = jnp.arange(B)[:, None, None]
    hidx = jnp.arange(H)[None, :, None]
    slope = slopes[:, None, None]

    def chunk(ci):
        t0 = ci * MOBA_QCHUNK
        qc = lax.dynamic_slice_in_dim(q, t0, MOBA_QCHUNK, axis=2)
        tpos = t0 + jnp.arange(MOBA_QCHUNK)
        b0 = (t0 // MOBA_BLOCK) * MOBA_BLOCK
        k_own = lax.dynamic_slice_in_dim(kp, b0, MOBA_BLOCK, axis=2)
        v_own = lax.dynamic_slice_in_dim(vp, b0, MOBA_BLOCK, axis=2)
        spos_own = b0 + offs
        dist_own = (tpos[:, None] - spos_own[None, :]).astype(jnp.float32)
        l_own = jnp.einsum('bhqd,bhkd->bhqk', qc, k_own).astype(jnp.float32) * scale - slope * dist_own
        l_own = jnp.where(spos_own[None, :] <= tpos[:, None], l_own, NEG_INF)
        sel_c = lax.dynamic_slice_in_dim(sel, t0, MOBA_QCHUNK, axis=2)
        val_c = lax.dynamic_slice_in_dim(sel_valid, t0, MOBA_QCHUNK, axis=2)
        spos_sel = (sel_c[..., None] * MOBA_BLOCK + offs).reshape(B, H, MOBA_QCHUNK, ksel * MOBA_BLOCK)
        flat = spos_sel.reshape(B, H, MOBA_QCHUNK * ksel * MOBA_BLOCK)
        k_sel = kp[bidx, hidx, flat].reshape(B, H, MOBA_QCHUNK, ksel * MOBA_BLOCK, hd)
        v_sel = vp[bidx, hidx, flat].reshape(B, H, MOBA_QCHUNK, ksel * MOBA_BLOCK, hd)
        dist_sel = (tpos[:, None] - spos_sel).astype(jnp.float32)
        l_sel = jnp.einsum('bhqd,bhqkd->bhqk', qc, k_sel).astype(jnp.float32) * scale - slope * dist_sel
        l_sel = jnp.where(jnp.repeat(val_c, MOBA_BLOCK, axis=-1), l_sel, NEG_INF)
        p = jax.nn.softmax(jnp.concatenate([l_own, l_sel], axis=-1), axis=-1).astype(v.dtype)
        return (jnp.einsum('bhqk,bhkd->bhqd', p[..., :MOBA_BLOCK], v_own)
                + jnp.einsum('bhqk,bhqkd->bhqd', p[..., MOBA_BLOCK:], v_sel))

    outs = lax.map(chunk, jnp.arange(S // MOBA_QCHUNK))
    return outs.transpose(1, 2, 0, 3, 4).reshape(B, H, S, hd)


def forgetting_attention(q, k, v, log_f):
    B, H, S, hd = q.shape
    F = jnp.cumsum(log_f, axis=-1)
    spos = jnp.arange(S)
    scale = HEAD_DIM ** -0.5

    def block(bi):
        t0 = bi * FOX_QBLOCK
        qb = lax.dynamic_slice_in_dim(q, t0, FOX_QBLOCK, axis=2)
        Fq = lax.dynamic_slice_in_dim(F, t0, FOX_QBLOCK, axis=2)
        tpos = t0 + jnp.arange(FOX_QBLOCK)
        l = jnp.einsum('bhqd,bhkd->bhqk', qb, k).astype(jnp.float32) * scale + Fq[..., None] - F[:, :, None, :]
        l = jnp.where(spos[None, :] <= tpos[:, None], l, NEG_INF)
        p = jax.nn.softmax(l, axis=-1).astype(v.dtype)
        return jnp.einsum('bhqk,bhkd->bhqd', p, v)

    outs = lax.map(block, jnp.arange(S // FOX_QBLOCK))
    return outs.transpose(1, 2, 0, 3, 4).reshape(B, H, S, hd)


def peer_ffn(h, w_pq, sub_keys, expert_u, expert_v):
    B, S, D = h.shape
    q = (h @ w_pq).reshape(B, S, PEER_HEADS, 2, PEER_HALF)
    s = jnp.einsum('bshcd,hcnd->bshcn', q, sub_keys).astype(jnp.float32)
    sv, si = lax.top_k(s, PEER_TOPK)
    cand = (sv[..., 0, :, None] + sv[..., 1, None, :]).reshape(B, S, PEER_HEADS, PEER_TOPK * PEER_TOPK)
    cidx = (si[..., 0, :, None] * PEER_NKEYS + si[..., 1, None, :]).reshape(B, S, PEER_HEADS, PEER_TOPK * PEER_TOPK)
    top_s, top_c = lax.top_k(cand, PEER_TOPK)
    eidx = jnp.take_along_axis(cidx, top_c, axis=-1)
    g = jax.nn.softmax(top_s, axis=-1)
    n = (B * S) // PEER_TCHUNK
    kk = PEER_HEADS * PEER_TOPK
    hf = h.reshape(n, PEER_TCHUNK, D)
    ef = eidx.reshape(n, PEER_TCHUNK, kk)
    gf = g.reshape(n, PEER_TCHUNK, kk)

    def chunk(args):
        hc, ec, gc = args
        u = expert_u[ec]
        a = jax.nn.gelu(jnp.einsum('td,tkd->tk', hc, u).astype(jnp.float32), approximate=False)
        w = (gc * a).astype(h.dtype)
        return jnp.einsum('tk,tkd->td', w, expert_v[ec])

    y = lax.map(chunk, (hf, ef, gf))
    return y.reshape(B, S, D)


def setup_inputs(seed: int = 0) -> dict:
    key = jax.random.key(seed)
    ks = jax.random.split(key, 18)
    f32 = jnp.float32
    D = D_MODEL
    nrm = lambda k, shp, s: jax.random.normal(k, shp, f32) * s
    return {
        "x": nrm(ks[0], (BATCH, SEQ, D), 1.0),
        "c": nrm(ks[1], (BATCH, D), 1.0),
        "w_ada": nrm(ks[2], (DEPTH, D, N_MOD * D), 0.5 * D ** -0.5),
        "b_ada": nrm(ks[3], (DEPTH, N_MOD * D), 0.01),
        "norm1_g": 1.0 + nrm(ks[4], (DEPTH, D), 0.02),
        "w_in": nrm(ks[5], (DEPTH, D, D_IN), D ** -0.5),
        "b_f": jax.random.uniform(ks[6], (DEPTH, N_FOX), f32, 1.0, 6.0),
        "q_norm_moba": 1.0 + nrm(ks[7], (DEPTH, HEAD_DIM), 0.02),
        "k_norm_moba": 1.0 + nrm(ks[8], (DEPTH, HEAD_DIM), 0.02),
        "q_norm_fox": 1.0 + nrm(ks[9], (DEPTH, HEAD_DIM), 0.02),
        "k_norm_fox": 1.0 + nrm(ks[10], (DEPTH, HEAD_DIM), 0.02),
        "w_out": nrm(ks[11], (DEPTH, D, D), D ** -0.5),
        "norm2_g": 1.0 + nrm(ks[12], (DEPTH, D), 0.02),
        "w_pq": nrm(ks[13], (DEPTH, D, PEER_HEADS * PEER_DKEY), D ** -0.5),
        "peer_sub_keys": nrm(ks[14], (DEPTH, PEER_HEADS, 2, PEER_NKEYS, PEER_HALF), PEER_HALF ** -0.5),
        "peer_u": nrm(ks[15], (DEPTH, PEER_EXPERTS, D), D ** -0.5),
        "peer_v": nrm(ks[16], (DEPTH, PEER_EXPERTS, D), PEER_HEADS ** -0.5),
    }


def reference(x, c, w_ada, b_ada, norm1_g, w_in, b_f, q_norm_moba, k_norm_moba,
              q_norm_fox, k_norm_fox, w_out, norm2_g, w_pq, peer_sub_keys, peer_u, peer_v):
    B, S, D = x.shape
    slopes = alibi_slopes(N_MOBA)
    c_act = jax.nn.silu(c)
    cuts = [D_MOBA, 2 * D_MOBA, 3 * D_MOBA, 3 * D_MOBA + D_FOX, 3 * D_MOBA + 2 * D_FOX, 3 * D_MOBA + 3 * D_FOX]
    for l in range(DEPTH):
        mod = (c_act @ w_ada[l] + b_ada[l]).reshape(B, N_MOD, D)
        sh1, sc1, g1 = mod[:, 0], mod[:, 1], mod[:, 2]
        sh2, sc2, g2 = mod[:, 3], mod[:, 4], mod[:, 5]

        h = modulate(rms_norm(x, norm1_g[l]), sh1, sc1)
        proj = h @ w_in[l]
        qa, ka, va, qf, kf, vf, fg = jnp.split(proj, cuts, axis=-1)
        qa = rms_norm(split_heads(qa, N_MOBA), q_norm_moba[l])
        ka = rms_norm(split_heads(ka, N_MOBA), k_norm_moba[l])
        va = split_heads(va, N_MOBA)
        qf = rms_norm(split_heads(qf, N_FOX), q_norm_fox[l])
        kf = rms_norm(split_heads(kf, N_FOX), k_norm_fox[l])
        vf = split_heads(vf, N_FOX)
        log_f = jax.nn.log_sigmoid((fg + b_f[l]).astype(jnp.float32)).transpose(0, 2, 1)
        o_moba = moba_attention(qa, ka, va, slopes)
        o_fox = forgetting_attention(qf, kf, vf, log_f)
        mix = jnp.concatenate([merge_heads(o_moba), merge_heads(o_fox)], axis=-1)
        x = x + g1[:, None, :] * (mix @ w_out[l])

        h2 = modulate(rms_norm(x, norm2_g[l]), sh2, sc2)
        x = x + g2[:, None, :] * peer_ffn(h2, w_pq[l], peer_sub_keys[l], peer_u[l], peer_v[l])
    return x
```

```cpp
#include <hip/hip_runtime.h>
#include <cstdio>
#include <cstdint>
namespace pg8 {
#define PG8_LAS __attribute__((address_space(3)))
typedef unsigned short bf16_t;
typedef short bf16x8 __attribute__((ext_vector_type(8)));
typedef float f32x4 __attribute__((ext_vector_type(4)));
typedef unsigned u32x4 __attribute__((ext_vector_type(4)));
constexpr int BM = 256, BK = 64, HALF = 128, HTB = HALF * BK * 2  , STAGE_BYTES = 8 * HTB, NXCD = 8, WGM = 8;

__host__ __device__ __forceinline__ int lds_byte(int r, int c) { const int st = (r >> 4) * 2 + (c >> 5), rr = r & 15, cc = c & 31, ob = rr * 64 + cc * 2; return st * 1024 + (ob ^ (((ob >> 9) & 1) << 5)); }
__host__ __device__ __forceinline__ void stage_rc(int b, int& R, int& C) { const int st = b / 1024, sb = b % 1024, swz = sb ^ (((sb >> 9) & 1) << 5); R = (st >> 1) * 16 + swz / 64; C = (st & 1) * 32 + (swz % 64) / 2; }
__host__ __device__ __forceinline__ int perm32(int rho) { const int n = rho >> 4, i = rho & 15; return 8 * (i >> 2) + 4 * n + (i & 3); }

struct Unit { int pm, pn; };
struct Gemm { const bf16_t* A; const bf16_t* Bt; int M, N, K; };

struct StaticOrder {
    int nM, nN, nwg, G, c;
    __host__ __device__ void init(int M, int N, int G_, int c_) { nM = M / BM; nN = N / BM; nwg = nM * nN; G = G_; c = c_; }
    __host__ __device__ bool next(int i, Unit& u) const {
        const long L = (long)i * G + c; if (L >= nwg) return false;
        int wgid = (int)L; { const int q = nwg / NXCD, r = nwg % NXCD, xcd = wgid % NXCD, off = wgid / NXCD; wgid = (xcd < r ? xcd * (q + 1) : r * (q + 1) + (xcd - r) * q) + off; }
        const int nig = WGM * nN, gid = wgid / nig, fm = gid * WGM, gsz = (nM - fm) < WGM ? (nM - fm) : WGM;
        u.pm = fm + ((wgid % nig) % gsz); u.pn = (wgid % nig) / gsz; return true;
    }
    __device__ __forceinline__ void a_ready(const Unit&) const {}
    __device__ __forceinline__ void done(const Unit&) const {}
};

__device__ __forceinline__ unsigned cvt_pk_bf16(float lo, float hi) { unsigned r; asm volatile("v_cvt_pk_bf16_f32 %0, %1, %2" : "=v"(r) : "v"(lo), "v"(hi)); return r; }
typedef float f32x2 __attribute__((ext_vector_type(2)));
__device__ __forceinline__ f32x2 gelu_pk(f32x2 v) {
    const f32x2 av = __builtin_elementwise_abs(v), d = av * 0.2316418882f + 1.0f;
    f32x2 t; t.x = __builtin_amdgcn_rcpf(d.x); t.y = __builtin_amdgcn_rcpf(d.y);
    f32x2 q = t * 0.5307027145f + (-0.7265760135f); q = q * t + 0.7107068705f; q = q * t + (-0.142248368f); q = q * t + 0.127414796f; q = q * t;
    const f32x2 s = (v * v) * (-0.72134752044f);
    f32x2 e; e.x = __builtin_amdgcn_exp2f(s.x); e.y = __builtin_amdgcn_exp2f(s.y);
    const f32x2 m = v * (q * e), r = v - m;
    f32x2 o; o.x = v.x < 0.f ? m.x : r.x; o.y = v.y < 0.f ? m.y : r.y; return o;
}

template <int ACT  > struct EpiBf16 {
    static constexpr bool PERM = true, AFTER_DRAIN = false; static_assert(ACT == 0 || ACT == 1, "EpiBf16: ACT is 0 (none) or 1 (gelu_pk)");
    bf16_t* O; int ldc; const float* bias; int split_cols; size_t split_stride; float scale0;
    __device__ __forceinline__ void operator()(const f32x4 (&acc)[2][2][4][2], const Unit& u, int wr, int wc, int fr, int fq) const {
        const int row0 = u.pm * BM + wr * 64 + fr; int colt = u.pn * BM; bf16_t* base = O;
        float sc = 1.f; if (split_cols) { const int t = colt / split_cols; base += (size_t)t * split_stride; colt -= t * split_cols; if (t == 0) sc = scale0; }
        const int col0 = colt + wc * 32 + 8 * fq, bcol0 = u.pn * BM + wc * 32 + 8 * fq;
        f32x4 bv[2][2];
#pragma unroll
        for (int bj = 0; bj < 2; ++bj)
#pragma unroll
            for (int n = 0; n < 2; ++n) bv[bj][n] = bias ? *(const f32x4*)(bias + bcol0 + bj * HALF + 4 * n) : (f32x4){0.f, 0.f, 0.f, 0.f};
#pragma unroll
        for (int ai = 0; ai < 2; ++ai)
#pragma unroll
            for (int m = 0; m < 4; ++m) { bf16_t* rowp = base + (size_t)(row0 + ai * HALF + m * 16) * ldc + col0;
#pragma unroll
                for (int bj = 0; bj < 2; ++bj) { f32x4 v0 = acc[ai][bj][m][0] + bv[bj][0], v1 = acc[ai][bj][m][1] + bv[bj][1];
                    if (ACT == 1) { f32x2 a = gelu_pk((f32x2){v0[0], v0[1]}), b = gelu_pk((f32x2){v0[2], v0[3]}), c = gelu_pk((f32x2){v1[0], v1[1]}), d = gelu_pk((f32x2){v1[2], v1[3]});
                        v0 = (f32x4){a.x, a.y, b.x, b.y}; v1 = (f32x4){c.x, c.y, d.x, d.y}; }
                    v0 = v0 * sc; v1 = v1 * sc; u32x4 w; w.x = cvt_pk_bf16(v0[0], v0[1]); w.y = cvt_pk_bf16(v0[2], v0[3]); w.z = cvt_pk_bf16(v1[0], v1[1]); w.w = cvt_pk_bf16(v1[2], v1[3]);
                    *(u32x4*)(rowp + bj * HALF) = w; } }
    }
};
typedef int i32x4 __attribute__((ext_vector_type(4)));
template <bool I8> struct AccSel { typedef f32x4 type; };
template <> struct AccSel<true> { typedef i32x4 type; };
template <bool I8> struct EpiInProj {
    static constexpr bool PERM = true, AFTER_DRAIN = false;
    typedef typename AccSel<I8>::type acc_t;
    bf16_t* O; int ldc; int col_base; const float* rowscale;
    const float* gtab;
    float* kmean; PG8_LAS float* xs; float eps;
    static __device__ __forceinline__ f32x4 tof(const f32x4& a) { return a; }
    static __device__ __forceinline__ f32x4 tof(const i32x4& a) { return __builtin_convertvector(a, f32x4); }
    __device__ __forceinline__ void operator()(const acc_t (&acc)[2][2][4][2], const Unit& u, int wr, int wc, int fr, int fq) const {
        asm volatile("" : "+v"(fr), "+v"(fq));
        const int colt = col_base + u.pn * BM, kind = colt >> 11;
        const int row0 = u.pm * BM + wr * 64 + fr;
        bf16_t* obase = O + (size_t)row0 * ldc + colt + wc * 32 + 8 * fq;
        if (kind == 2 || kind == 5) {
#pragma unroll
            for (int ai = 0; ai < 2; ++ai)
#pragma unroll
                for (int m = 0; m < 4; ++m) { const float rs = I8 ? rowscale[row0 + ai * HALF + m * 16] : 1.f; bf16_t* rowp = obase + (size_t)(ai * HALF + m * 16) * ldc;
#pragma unroll
                    for (int bj = 0; bj < 2; ++bj) { const f32x4 v0 = tof(acc[ai][bj][m][0]) * rs, v1 = tof(acc[ai][bj][m][1]) * rs;
                        u32x4 w; w.x = cvt_pk_bf16(v0[0], v0[1]); w.y = cvt_pk_bf16(v0[2], v0[3]); w.z = cvt_pk_bf16(v1[0], v1[1]); w.w = cvt_pk_bf16(v1[2], v1[3]);
                        *(u32x4*)(rowp + bj * HALF) = w; } }
            return;
        }
#pragma unroll
        for (int ai = 0; ai < 2; ++ai)
#pragma unroll
            for (int m = 0; m < 4; ++m)
#pragma unroll
                for (int bj = 0; bj < 2; ++bj) { const f32x4 a0 = tof(acc[ai][bj][m][0]), a1 = tof(acc[ai][bj][m][1]);
                    float s = (a0[0] * a0[0] + a0[1] * a0[1]) + (a0[2] * a0[2] + a0[3] * a0[3]) + (a1[0] * a1[0] + a1[1] * a1[1]) + (a1[2] * a1[2] + a1[3] * a1[3]);
                    s += __shfl_xor(s, 16); s += __shfl_xor(s, 32);
                    if (fq == 0) xs[(((wr * 2 + bj) * 128) + ai * 64 + m * 16 + fr) * 4 + wc] = s;
                    asm volatile("" ::: "memory"); }
        asm volatile("s_waitcnt lgkmcnt(0)" ::: "memory"); __builtin_amdgcn_s_barrier(); asm volatile("" ::: "memory");
        if (kind == 1) pass2<true>(acc, u, colt, kind, row0, obase, wr, wc, fr, fq); else pass2<false>(acc, u, colt, kind, row0, obase, wr, wc, fr, fq);
    }
    template <bool KM> __device__ __forceinline__ void pass2(const acc_t (&acc)[2][2][4][2], const Unit& u, int colt, int kind, int row0, bf16_t* obase, int wr, int wc, int fr, int fq) const {
        const float* gain = gtab + kind * 128;
        const f32x4 gv0 = *(const f32x4*)(gain + wc * 32 + 8 * fq), gv1 = *(const f32x4*)(gain + wc * 32 + 8 * fq + 4);
        f32x4 cs[2][2];
#pragma unroll
        for (int bj = 0; bj < 2; ++bj) { cs[bj][0] = (f32x4){0.f, 0.f, 0.f, 0.f}; cs[bj][1] = cs[bj][0]; }
#pragma unroll
        for (int ai = 0; ai < 2; ++ai)
#pragma unroll
            for (int m = 0; m < 4; ++m) { const float rs = I8 ? rowscale[row0 + ai * HALF + m * 16] : 1.f; bf16_t* rowp = obase + (size_t)(ai * HALF + m * 16) * ldc;
#pragma unroll
                for (int bj = 0; bj < 2; ++bj) {
                    const f32x4 p4 = *(const PG8_LAS f32x4*)(xs + (((wr * 2 + bj) * 128) + ai * 64 + m * 16 + fr) * 4);
                    const float tot = ((p4[0] + p4[1]) + (p4[2] + p4[3])) * (rs * rs);
                    const float mult = rs / sqrtf(tot * (1.0f / 128.0f) + eps);
                    acc_t r0 = acc[ai][bj][m][0], r1 = acc[ai][bj][m][1]; asm volatile("" : "+v"(r0), "+v"(r1));
                    const f32x4 v0 = tof(r0) * mult * gv0, v1 = tof(r1) * mult * gv1;
                    if (KM) { cs[bj][0] += v0; cs[bj][1] += v1; }
                    u32x4 w; w.x = cvt_pk_bf16(v0[0], v0[1]); w.y = cvt_pk_bf16(v0[2], v0[3]); w.z = cvt_pk_bf16(v1[0], v1[1]); w.w = cvt_pk_bf16(v1[2], v1[3]);
                    *(u32x4*)(rowp + bj * HALF) = w; }
                if (KM) asm volatile("" : "+v"(cs[0][0]), "+v"(cs[0][1]), "+v"(cs[1][0]), "+v"(cs[1][1]));
                asm volatile("" ::: "memory"); }
        if (KM) {
            const int b = u.pm >> 3, blk = u.pm & 7, h0 = (colt - 2048) >> 7;
#pragma unroll
            for (int bj = 0; bj < 2; ++bj)
#pragma unroll
                for (int n = 0; n < 2; ++n)
#pragma unroll
                    for (int j = 0; j < 4; ++j) { float c = cs[bj][n][j];
                        c += __shfl_xor(c, 1); c += __shfl_xor(c, 2); c += __shfl_xor(c, 4); c += __shfl_xor(c, 8);
                        if (fr == 0) (void)__hip_atomic_fetch_add(kmean + (((size_t)b * 16 + h0 + bj) * 8 + blk) * 128 + wc * 32 + 8 * fq + 4 * n + j, c * (1.0f / 256.0f), __ATOMIC_RELAXED, __HIP_MEMORY_SCOPE_AGENT); }
        }
    }
};
template <bool I8> struct EpiResGate {
    static constexpr bool PERM = false, AFTER_DRAIN = false;
    typedef typename AccSel<I8>::type acc_t;
    const float* base; float* out; int ldc; const float* gate; int rows_per_batch; int gate_stride; const float* rowscale;
    static __device__ __forceinline__ f32x4 tof(const f32x4& a) { return a; }
    static __device__ __forceinline__ f32x4 tof(const i32x4& a) { return __builtin_convertvector(a, f32x4); }
    __device__ __forceinline__ void operator()(const acc_t (&acc)[2][2][4][2], const Unit& u, int wr, int wc, int fr, int fq) const {
        const int row0 = u.pm * BM + wr * 64 + fr, col0 = u.pn * BM + wc * 32 + 4 * fq;
        const int b = (u.pm * BM) / rows_per_batch;
        f32x4 gv[2][2];
#pragma unroll
        for (int bj = 0; bj < 2; ++bj)
#pragma unroll
            for (int n = 0; n < 2; ++n) gv[bj][n] = *(const f32x4*)(gate + (size_t)b * gate_stride + col0 + bj * HALF + n * 16);
#pragma unroll
        for (int ai = 0; ai < 2; ++ai)
#pragma unroll
            for (int m = 0; m < 4; ++m) { const size_t off = (size_t)(row0 + ai * HALF + m * 16) * ldc + col0; const float rs = I8 ? rowscale[row0 + ai * HALF + m * 16] : 1.f;
#pragma unroll
                for (int bj = 0; bj < 2; ++bj)
#pragma unroll
                    for (int n = 0; n < 2; ++n) { const f32x4 xb = *(const f32x4*)(base + off + bj * HALF + n * 16);
                        *(f32x4*)(out + off + bj * HALF + n * 16) = xb + gv[bj][n] * (tof(acc[ai][bj][m][n]) * rs); } }
    }
};

template <bool I8> struct EpiResGateBf {
    static constexpr bool PERM = true, AFTER_DRAIN = false;
    typedef typename AccSel<I8>::type acc_t;
    const float* base; bf16_t* O; int ldc; const float* gate; int rows_per_batch; int gate_stride; const float* rowscale;
    static __device__ __forceinline__ f32x4 tof(const f32x4& a) { return a; }
    static __device__ __forceinline__ f32x4 tof(const i32x4& a) { return __builtin_convertvector(a, f32x4); }
    __device__ __forceinline__ void operator()(const acc_t (&acc)[2][2][4][2], const Unit& u, int wr, int wc, int fr, int fq) const {
        const int row0 = u.pm * BM + wr * 64 + fr, col0 = u.pn * BM + wc * 32 + 8 * fq;
        const int b = (u.pm * BM) / rows_per_batch;
        f32x4 gv[2][2];
#pragma unroll
        for (int bj = 0; bj < 2; ++bj)
#pragma unroll
            for (int n = 0; n < 2; ++n) gv[bj][n] = *(const f32x4*)(gate + (size_t)b * gate_stride + col0 + bj * HALF + 4 * n);
#pragma unroll
        for (int ai = 0; ai < 2; ++ai)
#pragma unroll
            for (int m = 0; m < 4; ++m) { const size_t off = (size_t)(row0 + ai * HALF + m * 16) * ldc + col0; const float rs = I8 ? rowscale[row0 + ai * HALF + m * 16] : 1.f;
                f32x4 xv[2][2];
#pragma unroll
                for (int bj = 0; bj < 2; ++bj) { xv[bj][0] = *(const f32x4*)(base + off + bj * HALF); xv[bj][1] = *(const f32x4*)(base + off + bj * HALF + 4); }
#pragma unroll
                for (int bj = 0; bj < 2; ++bj) { const f32x4 v0 = xv[bj][0] + gv[bj][0] * (tof(acc[ai][bj][m][0]) * rs), v1 = xv[bj][1] + gv[bj][1] * (tof(acc[ai][bj][m][1]) * rs);
                    u32x4 w; w.x = cvt_pk_bf16(v0[0], v0[1]); w.y = cvt_pk_bf16(v0[2], v0[3]); w.z = cvt_pk_bf16(v1[0], v1[1]); w.w = cvt_pk_bf16(v1[2], v1[3]);
                    *(u32x4*)(O + off + bj * HALF) = w; } }
    }
};

struct EpiBf16RC {
    static constexpr bool PERM = true, AFTER_DRAIN = false;
    bf16_t* O; int ldc; const float* rowscale; const unsigned* colmax_bits;
    __device__ __forceinline__ void operator()(const i32x4 (&acc)[2][2][4][2], const Unit& u, int wr, int wc, int fr, int fq) const {
        asm volatile("" : "+v"(fr), "+v"(fq));
        const int row0 = u.pm * BM + wr * 64 + fr, col0 = u.pn * BM + wc * 32 + 8 * fq;
        f32x4 cv[2][2];
#pragma unroll
        for (int bj = 0; bj < 2; ++bj)
#pragma unroll
            for (int n = 0; n < 2; ++n) { const u32x4 b = *(const u32x4*)(colmax_bits + col0 + bj * HALF + 4 * n);
                cv[bj][n] = (f32x4){__uint_as_float(b.x), __uint_as_float(b.y), __uint_as_float(b.z), __uint_as_float(b.w)} * (1.0f / 127.0f); }
#pragma unroll
        for (int ai = 0; ai < 2; ++ai)
#pragma unroll
            for (int m = 0; m < 4; ++m) { const float rs = rowscale[row0 + ai * HALF + m * 16]; bf16_t* rowp = O + (size_t)(row0 + ai * HALF + m * 16) * ldc + col0;
#pragma unroll
                for (int bj = 0; bj < 2; ++bj) { const f32x4 v0 = __builtin_convertvector(acc[ai][bj][m][0], f32x4) * rs * cv[bj][0], v1 = __builtin_convertvector(acc[ai][bj][m][1], f32x4) * rs * cv[bj][1];
                    u32x4 w; w.x = cvt_pk_bf16(v0[0], v0[1]); w.y = cvt_pk_bf16(v0[2], v0[3]); w.z = cvt_pk_bf16(v1[0], v1[1]); w.w = cvt_pk_bf16(v1[2], v1[3]);
                    *(u32x4*)(rowp + bj * HALF) = w; } }
    }
};
__device__ __forceinline__ f32x4 mma_step(f32x4 c, bf16x8 b, bf16x8 a) { return __builtin_amdgcn_mfma_f32_16x16x32_bf16(b, a, c, 0, 0, 0); }
__device__ __forceinline__ i32x4 mma_step(i32x4 c, bf16x8 b, bf16x8 a) { return __builtin_amdgcn_mfma_i32_16x16x64_i8(__builtin_bit_cast(i32x4, b), __builtin_bit_cast(i32x4, a), c, 0, 0, 0); }
template <class Epi, class Sched, bool ALIGN_EPI = false, bool SP2 = false, bool I8 = false>
__device__ __forceinline__ void gemm_phase(PG8_LAS unsigned char* lds, const Gemm g, const Sched& S, const Epi& E) {
    const int tid = threadIdx.x, wid = __builtin_amdgcn_readfirstlane(tid >> 6), lane = tid & 63, wr = wid >> 2, wc = wid & 3, fr = lane & 15, fq = lane >> 4;
    const int K = g.K, nt = K / BK;
    unsigned voffA[2], voffB[2];
#pragma unroll
    for (int i = 0; i < 2; ++i) { int R, C; stage_rc(tid * 16 + i * 8192, R, C); const int Rb = Epi::PERM ? ((R & ~31) + perm32(R & 31)) : R;
        voffA[i] = (unsigned)(R * K + C) * 2u; voffB[i] = (unsigned)(Rb * K + C) * 2u; }
    const size_t kstep = (size_t)(BK * 2);
    const size_t hstep = (size_t)HALF * K * 2;
    const size_t tstep = 2 * hstep;
    const unsigned ldsw = (unsigned)wid * 1024u;
    const int aoff = lds_byte(wr * 64 + fr, fq * 8), boff = lds_byte(wc * 32 + fr, fq * 8);
#define PG8_SA(b, h) (((b) * 2 + (h)) * HTB)
#define PG8_SB(b, h) ((4 + (b) * 2 + (h)) * HTB)
#define PG8_STAGE(bufoff, gbase, voff) do { _Pragma("unroll") for (int _i = 0; _i < 2; ++_i) \
        __builtin_amdgcn_global_load_lds((const unsigned*)((const char*)(gbase) + (voff)[_i]), (PG8_LAS unsigned*)(lds + (bufoff) + ldsw + _i * 8192), 16, 0, 0); } while (0)
#define PG8_LDA(dst, b, h) do { _Pragma("unroll") for (int m = 0; m < 4; ++m) _Pragma("unroll") for (int k = 0; k < 2; ++k) dst[m][k] = *(const PG8_LAS bf16x8*)(lds + PG8_SA(b, h) + aoff + m * 2048 + k * 1024); } while (0)
#define PG8_LDB(dst, b, h) do { _Pragma("unroll") for (int n = 0; n < 2; ++n) _Pragma("unroll") for (int k = 0; k < 2; ++k) dst[n][k] = *(const PG8_LAS bf16x8*)(lds + PG8_SB(b, h) + boff + n * 2048 + k * 1024); } while (0)
#define PG8_MMA(ai, bj, At, Bt) do { __builtin_amdgcn_s_setprio(1); _Pragma("unroll") for (int m = 0; m < 4; ++m) _Pragma("unroll") for (int n = 0; n < 2; ++n) _Pragma("unroll") for (int k = 0; k < 2; ++k) \
        acc[ai][bj][m][n] = mma_step(acc[ai][bj][m][n], Bt[n][k], At[m][k]); __builtin_amdgcn_s_setprio(0); } while (0)
#define PG8_WAIT_V(n) asm volatile("s_waitcnt vmcnt(" #n ")" ::: "memory")
#define PG8_WAIT_L(n) asm volatile("s_waitcnt lgkmcnt(" #n ")" ::: "memory")
#define PG8_BAR __builtin_amdgcn_s_barrier()
#define PG8_SCHED __builtin_amdgcn_sched_barrier(0)
    Unit cur, nxt; int ui = 0;
    if (!S.next(0, cur)) return;
    typedef typename AccSel<I8>::type acc_t;
    acc_t acc[2][2][4][2];
#pragma unroll
    for (int a = 0; a < 2; ++a)
#pragma unroll
        for (int b = 0; b < 2; ++b)
#pragma unroll
            for (int m = 0; m < 4; ++m)
#pragma unroll
                for (int n = 0; n < 2; ++n) acc[a][b][m][n] = (acc_t){0, 0, 0, 0};
    bf16x8 At[4][2], B0[2][2], B1[2][2];
    const char* cA = (const char*)g.A + (size_t)cur.pm * tstep; const char* cB = (const char*)g.Bt + (size_t)cur.pn * tstep;
    S.a_ready(cur);
    if constexpr (SP2) {
        PG8_STAGE(PG8_SB(0, 0), cB, voffB); PG8_STAGE(PG8_SB(0, 1), cB + hstep, voffB); PG8_STAGE(PG8_SA(0, 0), cA, voffA); PG8_STAGE(PG8_SA(0, 1), cA + hstep, voffA);
        if (wr == 1) PG8_BAR;
        PG8_WAIT_V(2); PG8_BAR;
        PG8_STAGE(PG8_SB(1, 0), cB + kstep, voffB); PG8_STAGE(PG8_SA(1, 0), cA + kstep, voffA); PG8_STAGE(PG8_SB(1, 1), cB + hstep + kstep, voffB);
        PG8_WAIT_V(6); PG8_BAR;
    } else {
        PG8_STAGE(PG8_SB(0, 0), cB, voffB); PG8_STAGE(PG8_SA(0, 0), cA, voffA); PG8_STAGE(PG8_SB(0, 1), cB + hstep, voffB); PG8_STAGE(PG8_SA(0, 1), cA + hstep, voffA);
        if (wr == 1) PG8_BAR;
        PG8_WAIT_V(4); PG8_BAR;
        PG8_STAGE(PG8_SB(1, 0), cB + kstep, voffB); PG8_STAGE(PG8_SA(1, 0), cA + kstep, voffA); PG8_STAGE(PG8_SB(1, 1), cB + hstep + kstep, voffB);
        PG8_WAIT_V(6); PG8_BAR;
    }
    for (;;) {
        const bool has_next = S.next(ui + 1, nxt);
        const char* nA = has_next ? (const char*)g.A + (size_t)nxt.pm * tstep : cA; const char* nB = has_next ? (const char*)g.Bt + (size_t)nxt.pn * tstep : cB;
        for (int t = 0; t < nt; t += 2) {
            const bool last = (t == nt - 2);
            const char* a1 = cA + (size_t)(t + 1) * kstep;
            const char* a2 = last ? nA : cA + (size_t)(t + 2) * kstep; const char* b2 = last ? nB : cB + (size_t)(t + 2) * kstep;
            const char* a3 = a2 + kstep; const char* b3 = b2 + kstep;
            if (last && has_next) S.a_ready(nxt);
            if constexpr (SP2) {
            PG8_LDB(B0, 0, 0); PG8_LDB(B1, 0, 1); PG8_SCHED; PG8_LDA(At, 0, 0); PG8_STAGE(PG8_SA(1, 1), a1 + hstep, voffA);
            PG8_WAIT_V(8); PG8_WAIT_L(0); PG8_BAR; PG8_MMA(0, 0, At, B0); PG8_MMA(0, 1, At, B1); PG8_BAR; PG8_SCHED;
            PG8_LDA(At, 0, 1); PG8_STAGE(PG8_SB(0, 0), b2, voffB); PG8_STAGE(PG8_SB(0, 1), b2 + hstep, voffB); PG8_STAGE(PG8_SA(0, 0), a2, voffA);
            PG8_WAIT_V(8); PG8_WAIT_L(0); PG8_BAR; PG8_MMA(1, 0, At, B0); PG8_MMA(1, 1, At, B1); PG8_BAR; PG8_SCHED;
            PG8_LDB(B0, 1, 0); PG8_LDB(B1, 1, 1); PG8_SCHED; PG8_LDA(At, 1, 0); PG8_STAGE(PG8_SA(0, 1), a2 + hstep, voffA);
            PG8_WAIT_V(8); PG8_WAIT_L(0); PG8_BAR; PG8_MMA(0, 0, At, B0); PG8_MMA(0, 1, At, B1); PG8_BAR; PG8_SCHED;
            PG8_LDA(At, 1, 1); PG8_STAGE(PG8_SB(1, 0), b3, voffB); PG8_STAGE(PG8_SB(1, 1), b3 + hstep, voffB); PG8_STAGE(PG8_SA(1, 0), a3, voffA);
            PG8_WAIT_V(8); PG8_WAIT_L(0); PG8_BAR; PG8_MMA(1, 0, At, B0); PG8_MMA(1, 1, At, B1); PG8_BAR; PG8_SCHED;
            } else {
            PG8_LDB(B0, 0, 0); PG8_SCHED; PG8_LDA(At, 0, 0); PG8_STAGE(PG8_SA(1, 1), a1 + hstep, voffA);
            PG8_WAIT_L(8); PG8_BAR; PG8_WAIT_L(0); PG8_MMA(0, 0, At, B0); PG8_BAR; PG8_SCHED;
            PG8_LDB(B1, 0, 1); PG8_STAGE(PG8_SB(0, 0), b2, voffB);
            PG8_BAR; PG8_WAIT_L(0); PG8_MMA(0, 1, At, B1); PG8_BAR;
            PG8_LDA(At, 0, 1); PG8_STAGE(PG8_SA(0, 0), a2, voffA);
            PG8_BAR; PG8_WAIT_L(0); PG8_MMA(1, 0, At, B0); PG8_BAR; PG8_SCHED;
            PG8_STAGE(PG8_SB(0, 1), b2 + hstep, voffB);
            PG8_WAIT_V(6); PG8_BAR; PG8_MMA(1, 1, At, B1); PG8_BAR;
            PG8_LDB(B0, 1, 0); PG8_SCHED; PG8_LDA(At, 1, 0); PG8_STAGE(PG8_SA(0, 1), a2 + hstep, voffA);
            PG8_WAIT_L(8); PG8_BAR; PG8_WAIT_L(0); PG8_MMA(0, 0, At, B0); PG8_BAR; PG8_SCHED;
            PG8_LDB(B1, 1, 1); PG8_STAGE(PG8_SB(1, 0), b3, voffB);
            PG8_BAR; PG8_WAIT_L(0); PG8_MMA(0, 1, At, B1); PG8_BAR;
            PG8_LDA(At, 1, 1); PG8_STAGE(PG8_SA(1, 0), a3, voffA);
            PG8_BAR; PG8_WAIT_L(0); PG8_MMA(1, 0, At, B0); PG8_BAR; PG8_SCHED;
            PG8_STAGE(PG8_SB(1, 1), b3 + hstep, voffB);
            PG8_WAIT_V(6); PG8_BAR; PG8_MMA(1, 1, At, B1); PG8_BAR;
            }
        }
        if constexpr (ALIGN_EPI) { if (wr == 0) PG8_BAR; }
        if constexpr (!Epi::AFTER_DRAIN) { E(acc, cur, wr, wc, fr, fq); S.done(cur); }
        if (!has_next) break;
#pragma unroll
        for (int a = 0; a < 2; ++a)
#pragma unroll
            for (int b = 0; b < 2; ++b)
#pragma unroll
                for (int m = 0; m < 4; ++m)
#pragma unroll
                    for (int n = 0; n < 2; ++n) acc[a][b][m][n] = (acc_t){0, 0, 0, 0};
        cur = nxt; cA = nA; cB = nB; ++ui;
        if constexpr (ALIGN_EPI) { if (wr == 1) PG8_BAR; }
    }
    PG8_WAIT_V(0);
    if constexpr (!ALIGN_EPI) { if (wr == 0) PG8_BAR; }
    PG8_BAR;
    if constexpr (Epi::AFTER_DRAIN) { E.fused(acc, cur, wr, wc, fr, fq, lds, wid, lane); S.done(cur); }
#undef PG8_SA
#undef PG8_SB
#undef PG8_STAGE
#undef PG8_LDA
#undef PG8_LDB
#undef PG8_MMA
#undef PG8_WAIT_V
#undef PG8_WAIT_L
#undef PG8_BAR
#undef PG8_SCHED
}
}
#define GAS __attribute__((address_space(1)))
#define LAS __attribute__((address_space(3)))
#define XB_TMO      128
#define XB_XCNT(j)  (256  + 64 * (j))
#define XB_XSUB(j)  (1280 + 64 * (j))
#define XB_XGEN(j)  (2304 + 64 * (j))
#define XB_TOP      3328
#define XB_TOPGEN   3392
#define XCD_BAR_WORDS 3456
#define XB_SPIN_CAP (1u << 18)

__device__ __forceinline__ unsigned xb_ld(unsigned* p)              { return __hip_atomic_load(p, __ATOMIC_RELAXED, __HIP_MEMORY_SCOPE_AGENT); }
__device__ __forceinline__ unsigned xb_add(unsigned* p, unsigned v) { return __hip_atomic_fetch_add(p, v, __ATOMIC_RELAXED, __HIP_MEMORY_SCOPE_AGENT); }
__device__ __forceinline__ unsigned xb_xcc_id() { return (unsigned)__builtin_amdgcn_s_getreg((3 << 11) | 20) & 0xFu; }
#define XB_SPIN(cond, bar) do { unsigned _sp = 0; while (cond) { __builtin_amdgcn_s_sleep(1); \
    if ((++_sp & 255u) == 0u) { if (xb_ld(&(bar)[XB_TMO])) break; if (_sp > XB_SPIN_CAP) { atomicAdd(&(bar)[XB_TMO], 1u); break; } } } } while (0)

struct XcdBarrier {
    unsigned* bar; unsigned x;
    volatile LAS unsigned* st;
};

__device__ __forceinline__ XcdBarrier xcd_barrier_post(unsigned* bar, volatile LAS unsigned* st) {
    XcdBarrier b; b.bar = bar; b.x = xb_xcc_id(); b.st = st;
    if (threadIdx.x == 0) (void)xb_add(&bar[XB_XCNT(b.x)], 1u);
    return b;
}
__device__ __forceinline__ void xcd_barrier_complete(unsigned* bar, unsigned x, unsigned& nloc, unsigned& nx) {
    const unsigned G = gridDim.x * gridDim.y * gridDim.z;
    unsigned sum, cnt, mine, sp = 0u;
    for (;;) {
        sum = 0u; cnt = 0u; mine = 0u;
#pragma unroll
        for (unsigned j = 0; j < 16; ++j) { const unsigned c = xb_ld(&bar[XB_XCNT(j)]); sum += c; cnt += (c > 0u) ? 1u : 0u; mine = (j == x) ? c : mine; }
        if (sum == G) break;
        __builtin_amdgcn_s_sleep(1);
        if ((++sp & 255u) == 0u) { if (xb_ld(&bar[XB_TMO])) break; if (sp > XB_SPIN_CAP) { atomicAdd(&bar[XB_TMO], 1u); break; } }
    }
    nloc = mine > 0u ? mine : 1u; nx = cnt > 0u ? cnt : 1u;
}

__device__ __forceinline__ void xcd_barrier(const XcdBarrier& b) {
    asm volatile("s_waitcnt vmcnt(0)" ::: "memory");
    __syncthreads();
    if (threadIdx.x == 0) {
        unsigned* bar = b.bar;
        __builtin_amdgcn_s_waitcnt(0);
        unsigned nloc = b.st[0], nx = b.st[1];
        if (nloc == 0u) { xcd_barrier_complete(bar, b.x, nloc, nx); b.st[0] = nloc; b.st[1] = nx; }
        const unsigned old = xb_add(&bar[XB_XSUB(b.x)], 1u);
        const unsigned gen = old / nloc;
        if (old + 1u == (gen + 1u) * nloc) {
            __builtin_amdgcn_fence(__ATOMIC_RELEASE, "agent");
            asm volatile("s_waitcnt vmcnt(0)" ::: "memory");
            const unsigned og = xb_add(&bar[XB_TOP], 1u);
            const unsigned tg = og / nx;
            if (og + 1u == (tg + 1u) * nx) xb_add(&bar[XB_TOPGEN], 1u);
            else XB_SPIN(xb_ld(&bar[XB_TOPGEN]) == tg, bar);
            __builtin_amdgcn_fence(__ATOMIC_ACQUIRE, "agent");
            xb_add(&bar[XB_XGEN(b.x)], 1u);
            asm volatile("s_waitcnt vmcnt(0)" ::: "memory");
        } else {
            XB_SPIN(xb_ld(&bar[XB_XGEN(b.x)]) == gen, bar);
            __builtin_amdgcn_fence(__ATOMIC_ACQUIRE, "agent");
            asm volatile("s_waitcnt vmcnt(0)" ::: "memory");
        }
    }
    __syncthreads();
}
constexpr int NB = 4, SEQ = 2048, DM = 4096, NTOK = NB * SEQ, DIN = 12304, NQKV = 12288, HD = 128;
constexpr int NMOD = 6 * DM, PQ = 2048;
constexpr float EPS = 1e-6f;
constexpr int NWAVES = 8, NTHR = 512;
constexpr int NPH = 10;

constexpr size_t MiB = 1u << 20;
constexpr size_t WS_CTL = 0;
constexpr size_t WS_MOD = 1 * MiB;
constexpr size_t WS_KMEAN = 1 * MiB + 512 * 1024;
constexpr size_t ZERO_BYTES = 2 * MiB;
constexpr size_t WS_LOGF = 2 * MiB;
constexpr size_t WS_FCUM = 3 * MiB;
constexpr size_t WS_SKB = 4 * MiB;
constexpr size_t WS_EIDX = 8 * MiB;
constexpr size_t WS_GATE = 12 * MiB;
constexpr size_t WS_WINT = 16 * MiB;
constexpr size_t WS_WOT = 112 * MiB;
constexpr size_t WS_WPQT = 144 * MiB;
constexpr size_t WS_H = 160 * MiB;
constexpr size_t WS_PROJ = 224 * MiB;
constexpr size_t WS_MIX = 416 * MiB;
constexpr size_t WS_QP = 480 * MiB;
constexpr size_t WS_UB = 512 * MiB;
constexpr size_t WS_VB = 640 * MiB;
constexpr size_t WS_H2Q = 768 * MiB;
constexpr size_t WS_WINQ = 920 * MiB;
constexpr size_t WS_H1Q = 840 * MiB;
constexpr size_t WS_WOQ = 872 * MiB;
constexpr size_t WS_MIXQ = 888 * MiB;
constexpr size_t WS_END = 968 * MiB;
constexpr size_t WS_WINKN = 32 * MiB, WS_WOKN = 96 * MiB;
constexpr size_t WS_PQMAX = 1 * MiB + 786432;
constexpr size_t WS_WPQQ = 16 * MiB;
constexpr size_t WS_FGIMG = 6 * MiB;
constexpr size_t WS_SKOINV = 5 * MiB + 393216, WS_SKOF = 5 * MiB + 393216 + 16384, WS_MSC = 5 * MiB + 458752;
constexpr size_t WS_SKINV = 5 * MiB + 196608, WS_SKF = 5 * MiB + 196608 + 16384, WS_HSC1 = 5 * MiB + 262144, WS_GT = 5 * MiB + 327680;
constexpr size_t WS_USC = 5 * MiB, WS_VSC = 5 * MiB + 65536, WS_HSC = 5 * MiB + 131072;
constexpr int CW_BAR = 4096;

constexpr int LDS_BYTES = 163840, MISC_OFF = LDS_BYTES - 256;

#define GAS __attribute__((address_space(1)))
#define LAS __attribute__((address_space(3)))
typedef unsigned short bf16;
typedef unsigned v4u __attribute__((ext_vector_type(4)));
typedef unsigned v2u __attribute__((ext_vector_type(2)));
typedef float f32x4 __attribute__((ext_vector_type(4)));
typedef short bf16x8 __attribute__((ext_vector_type(8)));
#define LDS_WAIT() asm volatile("s_waitcnt lgkmcnt(0)" ::: "memory")

__device__ __forceinline__ unsigned f2bf(float f) { unsigned u = __builtin_bit_cast(unsigned, f); return (u + 0x7fffu + ((u >> 16) & 1u)) >> 16; }
__device__ __forceinline__ unsigned pk2(float lo, float hi) { return f2bf(lo) | (f2bf(hi) << 16); }
__device__ __forceinline__ float bf_lo(unsigned u) { return __uint_as_float(u << 16); }
__device__ __forceinline__ float bf_hi(unsigned u) { return __uint_as_float(u & 0xffff0000u); }
__device__ __forceinline__ float wave_sum(float v) {
#pragma unroll
    for (int o = 1; o < 64; o <<= 1) v += __shfl_xor(v, o);
    return v;
}
__device__ __forceinline__ int tokey(unsigned u) { const int s = (int)u; return s ^ ((s >> 31) & 0x7fffffff); }
__device__ __forceinline__ unsigned unkey(int k) { return (unsigned)(k ^ ((k >> 31) & 0x7fffffff)); }

template <int CTRL, int ROW_MASK> __device__ __forceinline__ float dpp_f(float v) { return __builtin_bit_cast(float, __builtin_amdgcn_update_dpp(0, __builtin_bit_cast(int, v), CTRL, ROW_MASK, 0xf, false)); }
#define WAVE_SUM63(v) do { v += dpp_f<0xB1, 0xf>(v); v += dpp_f<0x4E, 0xf>(v); v += dpp_f<0x141, 0xf>(v); v += dpp_f<0x140, 0xf>(v); v += dpp_f<0x142, 0xa>(v); v += dpp_f<0x143, 0xc>(v); } while (0)

typedef __bf16 bf16x2_t __attribute__((ext_vector_type(2)));
__device__ __forceinline__ float dot2bf(unsigned a, unsigned b, float acc) { return __builtin_amdgcn_fdot2_f32_bf16(__builtin_bit_cast(bf16x2_t, a), __builtin_bit_cast(bf16x2_t, b), acc, false); }
struct Args { const float* in[17]; float* out; unsigned char* ws; int ph_lo, ph_hi; };

__device__ __forceinline__ void transpose_item(const float* W, int ld, int K, bf16* WT, LAS float* scr, int kb, int nb, int lane) {
    const int k0 = 64 * kb, n0 = 32 * nb;
    float tv[32];
#pragma unroll
    for (int i = 0; i < 32; ++i) tv[i] = W[(size_t)(k0 + 2 * i + (lane >> 5)) * ld + n0 + (lane & 31)];
#pragma unroll
    for (int i = 0; i < 32; ++i) scr[(2 * i + (lane >> 5)) * 33 + (lane & 31)] = tv[i];
    LDS_WAIT();
    const int c = lane & 7;
#pragma unroll
    for (int j = 0; j < 4; ++j) { const int n = (lane >> 3) + 8 * j; const LAS float* s = scr + (8 * c) * 33 + n;
        v4u o; o.x = pk2(s[0 * 33], s[1 * 33]); o.y = pk2(s[2 * 33], s[3 * 33]); o.z = pk2(s[4 * 33], s[5 * 33]); o.w = pk2(s[6 * 33], s[7 * 33]);
        *(v4u*)(WT + (size_t)(n0 + n) * K + k0 + 8 * c) = o; }
    LDS_WAIT();
}

__device__ __forceinline__ void transpose_item_i8(const float* W, int ld, int K, unsigned char* WQ, const float* skinv, LAS float* scr, int kb, int n_src0, int n_dst0, int lane) {
    const int k0 = 64 * kb;
    float tv[32];
#pragma unroll
    for (int i = 0; i < 32; ++i) tv[i] = W[(size_t)(k0 + 2 * i + (lane >> 5)) * ld + n_src0 + (lane & 31)];
#pragma unroll
    for (int i = 0; i < 32; ++i) scr[(2 * i + (lane >> 5)) * 33 + (lane & 31)] = tv[i];
    const int c = lane & 3, nl = lane >> 2;
    float si[16];
#pragma unroll
    for (int q = 0; q < 4; ++q) { const f32x4 t = *(const f32x4*)(skinv + k0 + 16 * c + 4 * q); si[4 * q] = t.x; si[4 * q + 1] = t.y; si[4 * q + 2] = t.z; si[4 * q + 3] = t.w; }
    LDS_WAIT();
#pragma unroll
    for (int jj = 0; jj < 2; ++jj) { const int n = nl + 16 * jj; const LAS float* sp = scr + (16 * c) * 33 + n; v4u o;
#pragma unroll
        for (int q = 0; q < 4; ++q) { const int q0 = __float2int_rn(sp[(4 * q) * 33] * si[4 * q]), q1 = __float2int_rn(sp[(4 * q + 1) * 33] * si[4 * q + 1]), q2 = __float2int_rn(sp[(4 * q + 2) * 33] * si[4 * q + 2]), q3 = __float2int_rn(sp[(4 * q + 3) * 33] * si[4 * q + 3]);
            o[q] = ((unsigned)q0 & 255u) | (((unsigned)q1 & 255u) << 8) | (((unsigned)q2 & 255u) << 16) | (((unsigned)q3 & 255u) << 24); }
        *(v4u*)(WQ + (size_t)(n_dst0 + n) * K + k0 + 16 * c) = o; }
    LDS_WAIT();
}

__device__ __forceinline__ void ph0_prologue(const Args& a, LAS unsigned char* lds, int tid, int lane, int wave, int G) {
    const float* c = a.in[1]; const float* w_ada = a.in[2]; const float* b_ada = a.in[3];
    float* mod = (float*)(a.ws + WS_MOD);
    LAS float* cs = (LAS float*)lds;
    LAS f32x4* red = (LAS f32x4*)(lds + 65536);
    for (int i = tid; i < 4 * DM; i += NTHR) { const float cv = c[i]; cs[i] = cv / (1.f + __expf(-cv)); }
    __syncthreads();
#ifndef P0_DUPG
#define P0_DUPG 1
#endif
#ifndef P0_DUPC
#define P0_DUPC 1
#endif
    const int kg = tid / 24, cq = tid % 24;
    for (int rep_ = 0; rep_ < P0_DUPG; ++rep_)
    for (int it = blockIdx.x; it < 256; it += G) {
        if (tid < 504) {
            const float* wp = w_ada + (size_t)kg * NMOD + it * 96 + cq * 4;
            f32x4 acc0 = {0.f, 0.f, 0.f, 0.f}, acc1 = acc0, acc2 = acc0, acc3 = acc0;
            const int nrow = (DM - kg + 20) / 21;
#pragma unroll 8
            for (int i = 0; i < nrow; ++i) {
                const f32x4 w = *(const f32x4*)(wp + (size_t)(21 * i) * NMOD);
                const int k = kg + 21 * i;
                acc0 += cs[k] * w; acc1 += cs[DM + k] * w; acc2 += cs[2 * DM + k] * w; acc3 += cs[3 * DM + k] * w;
            }
            red[(kg * 4 + 0) * 24 + cq] = acc0; red[(kg * 4 + 1) * 24 + cq] = acc1; red[(kg * 4 + 2) * 24 + cq] = acc2; red[(kg * 4 + 3) * 24 + cq] = acc3;
        }
        __syncthreads();
        if (tid < 96) { const int b = tid / 24, q = tid % 24;
            f32x4 s = *(const f32x4*)(b_ada + it * 96 + q * 4);
            for (int g = 0; g < 21; ++g) s += red[(g * 4 + b) * 24 + q];
            *(f32x4*)(mod + (size_t)b * NMOD + it * 96 + q * 4) = s; }
        __syncthreads();
    }
    const int gw = blockIdx.x * NWAVES + wave, NGW = G * NWAVES;
    LAS float* scr = (LAS float*)(lds + 81920 + wave * 8448);
    { unsigned* pqmax = (unsigned*)(a.ws + WS_PQMAX);
      for (int it = gw; it < 2048; it += NGW) { const int cg = it & 63, slab = it >> 6; const float* wp = a.in[13] + (size_t)(slab * 128 + (lane >> 5)) * PQ + 32 * cg + (lane & 31); float mx = 0.f;
#pragma unroll 16
          for (int i = 0; i < 64; ++i) mx = fmaxf(mx, fabsf(wp[(size_t)(2 * i) * PQ]));
          mx = fmaxf(mx, __shfl_xor(mx, 32));
          if (lane < 32) atomicMax(pqmax + 32 * cg + lane, __float_as_uint(mx)); } }
    if (blockIdx.x == 0 && tid < 128) { float* gt = (float*)(a.ws + WS_GT); gt[tid] = a.in[7][tid]; gt[128 + tid] = a.in[8][tid]; gt[256 + tid] = 0.f; gt[384 + tid] = a.in[9][tid]; gt[512 + tid] = a.in[10][tid]; gt[640 + tid] = 0.f; }
    { const f32x4* sk = (const f32x4*)a.in[14]; v4u* skb = (v4u*)(a.ws + WS_SKB);
      for (int i = blockIdx.x * NTHR + tid; i < 32768; i += G * NTHR) { const f32x4 p = sk[2 * i], q = sk[2 * i + 1];
          v4u o; o.x = pk2(p.x, p.y); o.y = pk2(p.z, p.w); o.z = pk2(q.x, q.y); o.w = pk2(q.z, q.w); skb[i] = o; } }
    for (int ci = blockIdx.x * NTHR + tid; ci < 8192; ci += G * NTHR) { const int g = ci >> 3, q = ci & 7, kp = q >> 2, cq = q & 3, k = 4 * g + 2 * kp; const float* w_in = a.in[5];
        const f32x4 w0 = *(const f32x4*)(w_in + (size_t)k * DIN + NQKV + 4 * cq), w1 = *(const f32x4*)(w_in + (size_t)(k + 1) * DIN + NQKV + 4 * cq);
        v4u o; o.x = pk2(w0.x, w1.x); o.y = pk2(w0.y, w1.y); o.z = pk2(w0.z, w1.z); o.w = pk2(w0.w, w1.w);
        *(v4u*)(a.ws + WS_FGIMG + 128 * g + 16 * (q ^ ((g >> 1) & 7))) = o; }
    { const float* Uf = a.in[15]; const float* Vf = a.in[16]; float* usc = (float*)(a.ws + WS_USC); float* vsc = (float*)(a.ws + WS_VSC);
      for (int rep_ = 0; rep_ < P0_DUPC; ++rep_) {
      f32x4 vn[16];
      { const int r0 = gw; const f32x4* s0 = (const f32x4*)((r0 >= 16384 ? Vf : Uf) + (size_t)(r0 & 16383) * DM) + lane;
#pragma unroll
        for (int j = 0; j < 16; ++j) vn[j] = r0 < 16384 ? s0[64 * j] : (f32x4){0.f, 0.f, 0.f, 0.f}; }
      for (int r = gw; r < 16384; r += NGW) {
          const bool isv = false; const int e = r;
          f32x4 v[16]; float mx = 0.f;
#pragma unroll
          for (int j = 0; j < 16; ++j) { v[j] = vn[j]; mx = fmaxf(mx, fmaxf(fmaxf(fabsf(v[j].x), fabsf(v[j].y)), fmaxf(fabsf(v[j].z), fabsf(v[j].w)))); }
          { const int rn = r + NGW; if (rn < 16384) { const f32x4* sn = (const f32x4*)((rn >= 16384 ? Vf : Uf) + (size_t)(rn & 16383) * DM) + lane;
#pragma unroll
              for (int j = 0; j < 16; ++j) vn[j] = sn[64 * j]; } }
#pragma unroll
          for (int o = 1; o < 64; o <<= 1) mx = fmaxf(mx, __shfl_xor(mx, o));
          const float sc = mx > 0.f ? mx * (1.f / 127.f) : 1.f, inv = 1.f / sc;
          if (lane == 0) (isv ? vsc : usc)[e] = sc;
          unsigned char* dst = a.ws + (isv ? WS_VB : WS_UB) + (size_t)e * 128 + ((4 * lane) & 127);
          const int bias = isv ? 128 : 0;
#pragma unroll
          for (int j = 0; j < 16; ++j) {
              const int q0 = __float2int_rn(v[j].x * inv) + bias, q1 = __float2int_rn(v[j].y * inv) + bias, q2 = __float2int_rn(v[j].z * inv) + bias, q3 = __float2int_rn(v[j].w * inv) + bias;
              const unsigned pk = ((unsigned)q0 & 255u) | (((unsigned)q1 & 255u) << 8) | (((unsigned)q2 & 255u) << 16) | (((unsigned)q3 & 255u) << 24);
              *(unsigned*)(dst + (size_t)(2 * j + (lane >> 5)) * (16384 * 128)) = pk; }
      } } }
    { float* skinv = (float*)(a.ws + WS_SKOINV); float* skf = (float*)(a.ws + WS_SKOF); unsigned char* dq = a.ws + WS_WOKN;
      for (int k = gw; k < DM; k += NGW) {
          const f32x4* src = (const f32x4*)(a.in[11] + (size_t)k * DM) + lane; f32x4 v[16]; float mx = 0.f;
#pragma unroll
          for (int j = 0; j < 16; ++j) { v[j] = src[64 * j]; mx = fmaxf(mx, fmaxf(fmaxf(fabsf(v[j].x), fabsf(v[j].y)), fmaxf(fabsf(v[j].z), fabsf(v[j].w)))); }
#pragma unroll
          for (int o = 1; o < 64; o <<= 1) mx = fmaxf(mx, __shfl_xor(mx, o));
          const float sc = mx > 0.f ? mx * (1.f / 127.f) : 1.f, inv = 1.f / sc;
          if (lane == 0) { skf[k] = sc; skinv[k] = inv; }
          unsigned* dp = (unsigned*)(dq + (size_t)k * DM) + lane;
#pragma unroll
          for (int j = 0; j < 16; ++j) { const int q0 = __float2int_rn(v[j].x * inv), q1 = __float2int_rn(v[j].y * inv), q2 = __float2int_rn(v[j].z * inv), q3 = __float2int_rn(v[j].w * inv);
              dp[64 * j] = ((unsigned)q0 & 255u) | (((unsigned)q1 & 255u) << 8) | (((unsigned)q2 & 255u) << 16) | (((unsigned)q3 & 255u) << 24); } } }
    { float* skinv = (float*)(a.ws + WS_SKINV); float* skf = (float*)(a.ws + WS_SKF); unsigned char* dq = a.ws + WS_WINKN;
      for (int k = gw; k < DM; k += NGW) {
          const f32x4* src = (const f32x4*)(a.in[5] + (size_t)k * DIN) + lane; f32x4 v[48]; float mx = 0.f;
#pragma unroll
          for (int j = 0; j < 48; ++j) v[j] = src[64 * j];
#pragma unroll
          for (int j = 0; j < 48; ++j) mx = fmaxf(mx, fmaxf(fmaxf(fabsf(v[j].x), fabsf(v[j].y)), fmaxf(fabsf(v[j].z), fabsf(v[j].w))));
#pragma unroll
          for (int o = 1; o < 64; o <<= 1) mx = fmaxf(mx, __shfl_xor(mx, o));
          const float sc = mx > 0.f ? mx * (1.f / 127.f) : 1.f, inv = 1.f / sc;
          if (lane == 0) { skf[k] = sc; skinv[k] = inv; }
          unsigned* dp = (unsigned*)(dq + (size_t)k * NQKV) + lane;
#pragma unroll
          for (int j = 0; j < 48; ++j) { const int q0 = __float2int_rn(v[j].x * inv), q1 = __float2int_rn(v[j].y * inv), q2 = __float2int_rn(v[j].z * inv), q3 = __float2int_rn(v[j].w * inv);
              dp[64 * j] = ((unsigned)q0 & 255u) | (((unsigned)q1 & 255u) << 8) | (((unsigned)q2 & 255u) << 16) | (((unsigned)q3 & 255u) << 24); } } }
}

template <bool FG, bool WH = true, bool XB = false>
__device__ __forceinline__ void ph_norm(const float* xin, const float* gnorm, const float* sh, const float* sc, bf16* H, unsigned char* H2Q, float* HSC, const float* qcol,
                                        const float* w_in, const float* b_f, float* logf, LAS unsigned char* lds, int lane, int wave, int G) {
    const int gw = blockIdx.x * NWAVES + wave, NGW = G * NWAVES;
    const LAS unsigned char* wfl = lds;
    if (FG) {
        const v4u* img = (const v4u*)w_in; v4u t[16];
#pragma unroll
        for (int i = 0; i < 16; ++i) t[i] = img[threadIdx.x + NTHR * i];
#pragma unroll
        for (int i = 0; i < 16; ++i) *(LAS v4u*)(lds + 16 * (threadIdx.x + NTHR * i)) = t[i];
        __syncthreads();
    }
    for (int m = gw; m < NTOK; m += NGW) {
        int ln = lane; asm volatile("" : "+v"(ln));
        const int b = m / SEQ;
        const f32x4* xr = (const f32x4*)(xin + (size_t)m * DM) + ln;
        f32x4 v[16]; float ss = 0.f;
#pragma unroll
        for (int j = 0; j < 16; ++j) { if (XB) { const v2u t = ((const v2u*)((const bf16*)xin + (size_t)m * DM) + ln)[64 * j]; v[j] = (f32x4){bf_lo(t.x), bf_hi(t.x), bf_lo(t.y), bf_hi(t.y)}; } else v[j] = xr[64 * j];
            ss += (v[j].x * v[j].x + v[j].y * v[j].y) + (v[j].z * v[j].z + v[j].w * v[j].w); }
        ss = wave_sum(ss);
        const float rstd = 1.0f / sqrtf(ss * (1.f / DM) + EPS);
        v2u* ho = (v2u*)(H + (size_t)m * DM) + ln; float hmx = 0.f;
#pragma unroll
        for (int j = 0; j < 16; ++j) { const int col = 4 * ln + 256 * j;
            const f32x4 g = *(const f32x4*)(gnorm + col), s1 = *(const f32x4*)(sc + (size_t)b * NMOD + col), s0 = *(const f32x4*)(sh + (size_t)b * NMOD + col);
            const f32x4 hv = v[j] * rstd * g * (1.f + s1) + s0;
            if (!FG && WH) { v2u o; o.x = pk2(hv.x, hv.y); o.y = pk2(hv.z, hv.w); ho[64 * j] = o; }
            v[j] = hv;
            const f32x4 hq = FG ? hv * *(const f32x4*)(qcol + col) : hv;
            hmx = fmaxf(hmx, fmaxf(fmaxf(fabsf(hq.x), fabsf(hq.y)), fmaxf(fabsf(hq.z), fabsf(hq.w))));
            if (j == 7) asm volatile("" ::: "memory"); }
        {
#pragma unroll
            for (int o = 1; o < 64; o <<= 1) hmx = fmaxf(hmx, __shfl_xor(hmx, o));
            const float qs = hmx > 0.f ? hmx * (1.f / 127.f) : 1.f, qi = 1.f / qs;
            if (ln == 0) HSC[m] = qs;
            int lq = ln;
            unsigned* qo = (unsigned*)(H2Q + (size_t)m * DM) + lq;
            asm volatile("" ::: "memory");
            f32x4 qc[16];
#pragma unroll
            for (int j = 0; j < 16; ++j) qc[j] = FG ? *(const f32x4*)(qcol + 4 * ln + 256 * j) : (f32x4){1.f, 1.f, 1.f, 1.f};
#pragma unroll
            for (int j = 0; j < 16; ++j) { const f32x4 hq = v[j] * qc[j] * qi;
                const int q0 = __float2int_rn(hq.x), q1 = __float2int_rn(hq.y), q2 = __float2int_rn(hq.z), q3 = __float2int_rn(hq.w);
                qo[64 * j] = ((unsigned)q0 & 255u) | (((unsigned)q1 & 255u) << 8) | (((unsigned)q2 & 255u) << 16) | (((unsigned)q3 & 255u) << 24); }
        }
        if (FG) {
            float fa[16];
#pragma unroll
            for (int c = 0; c < 16; ++c) fa[c] = 0.f;
#pragma unroll
            for (int j = 0; j < 16; ++j) { const int g = ln + 64 * j; const LAS unsigned char* gp = wfl + 128 * g; const int sw = (g >> 1) & 7;
#pragma unroll
                for (int kp = 0; kp < 2; ++kp) { const unsigned hpk = pg8::cvt_pk_bf16(v[j][2 * kp], v[j][2 * kp + 1]);
#pragma unroll
                    for (int cq = 0; cq < 4; ++cq) { const v4u w = *(const LAS v4u*)(gp + 16 * ((4 * kp + cq) ^ sw));
                        fa[4 * cq + 0] = dot2bf(w.x, hpk, fa[4 * cq + 0]); fa[4 * cq + 1] = dot2bf(w.y, hpk, fa[4 * cq + 1]); fa[4 * cq + 2] = dot2bf(w.z, hpk, fa[4 * cq + 2]); fa[4 * cq + 3] = dot2bf(w.w, hpk, fa[4 * cq + 3]); } }
                asm volatile("" ::: "memory"); }
            float z = 0.f;
#pragma unroll
            for (int c = 0; c < 16; ++c) { float t = fa[c]; WAVE_SUM63(t); const float tot = __builtin_bit_cast(float, __builtin_amdgcn_readlane(__builtin_bit_cast(int, t), 63)); z = (ln == c) ? tot : z; }
            { int ll = ln;
              if (ll < 16) { z += b_f[ll]; logf[((size_t)b * 16 + ll) * SEQ + (m % SEQ)] = fminf(z, 0.f) - log1pf(__expf(-fabsf(z))); } }
        }
    }
}

template <bool FG>
__device__ __forceinline__ void ph_norm2(const float* xin, const float* gnorm, const float* sh, const float* sc, bf16* H, unsigned char* H2Q, float* HSC, const float* qcol,
                                        const float* w_in, const float* b_f, float* logf, LAS unsigned char* lds, int lane, int wave, int G) {
    const int gw = blockIdx.x * NWAVES + wave, NGW = G * NWAVES;
    const LAS unsigned char* wfl = lds;
    if (FG) {
        for (int ci = threadIdx.x; ci < 8192; ci += NTHR) { const int g = ci >> 3, q = ci & 7, kp = q >> 2, cq = q & 3, k = 4 * g + 2 * kp;
            const f32x4 w0 = *(const f32x4*)(w_in + (size_t)k * DIN + NQKV + 4 * cq), w1 = *(const f32x4*)(w_in + (size_t)(k + 1) * DIN + NQKV + 4 * cq);
            v4u o; o.x = pk2(w0.x, w1.x); o.y = pk2(w0.y, w1.y); o.z = pk2(w0.z, w1.z); o.w = pk2(w0.w, w1.w);
            *(LAS v4u*)(lds + 128 * g + 16 * (q ^ ((g >> 1) & 7))) = o; }
        __syncthreads();
    }
    for (int mp = gw; mp < NTOK / 2; mp += NGW) {
        const int m0 = 2 * mp, b = m0 / SEQ;
        f32x4 v[2][16]; float rstd[2];
#pragma unroll
        for (int r = 0; r < 2; ++r) { const f32x4* xr = (const f32x4*)(xin + (size_t)(m0 + r) * DM) + lane; float ss = 0.f;
#pragma unroll
            for (int j = 0; j < 16; ++j) { v[r][j] = xr[64 * j]; ss += (v[r][j].x * v[r][j].x + v[r][j].y * v[r][j].y) + (v[r][j].z * v[r][j].z + v[r][j].w * v[r][j].w); }
            ss = wave_sum(ss); rstd[r] = 1.0f / sqrtf(ss * (1.f / DM) + EPS); }
        float hmx[2] = {0.f, 0.f};
#pragma unroll
        for (int j = 0; j < 16; ++j) { const int col = 4 * lane + 256 * j;
            const f32x4 g = *(const f32x4*)(gnorm + col), s1 = *(const f32x4*)(sc + (size_t)b * NMOD + col), s0 = *(const f32x4*)(sh + (size_t)b * NMOD + col);
            const f32x4 ga = g * (1.f + s1);
            f32x4 qc = {1.f, 1.f, 1.f, 1.f}; if (FG) qc = *(const f32x4*)(qcol + col);
#pragma unroll
            for (int r = 0; r < 2; ++r) { const f32x4 hv = v[r][j] * rstd[r] * ga + s0;
                v2u o; o.x = pk2(hv.x, hv.y); o.y = pk2(hv.z, hv.w); ((v2u*)(H + (size_t)(m0 + r) * DM) + lane)[64 * j] = o;
                v[r][j] = hv;
                const f32x4 hq = hv * qc;
                hmx[r] = fmaxf(hmx[r], fmaxf(fmaxf(fabsf(hq.x), fabsf(hq.y)), fmaxf(fabsf(hq.z), fabsf(hq.w)))); }
            if (j & 1) asm volatile("" ::: "memory"); }
        {
            float qi[2];
#pragma unroll
            for (int r = 0; r < 2; ++r) {
#pragma unroll
                for (int o = 1; o < 64; o <<= 1) hmx[r] = fmaxf(hmx[r], __shfl_xor(hmx[r], o));
                const float qs = hmx[r] > 0.f ? hmx[r] * (1.f / 127.f) : 1.f; qi[r] = 1.f / qs;
                if (lane == 0) HSC[m0 + r] = qs; }
#pragma unroll
            for (int j = 0; j < 16; ++j) { f32x4 qc = {1.f, 1.f, 1.f, 1.f}; if (FG) qc = *(const f32x4*)(qcol + 4 * lane + 256 * j);
#pragma unroll
                for (int r = 0; r < 2; ++r) { const f32x4 hq = v[r][j] * qc * qi[r];
                    const int q0 = __float2int_rn(hq.x), q1 = __float2int_rn(hq.y), q2 = __float2int_rn(hq.z), q3 = __float2int_rn(hq.w);
                    ((unsigned*)(H2Q + (size_t)(m0 + r) * DM) + lane)[64 * j] = ((unsigned)q0 & 255u) | (((unsigned)q1 & 255u) << 8) | (((unsigned)q2 & 255u) << 16) | (((unsigned)q3 & 255u) << 24); }
                if (j & 1) asm volatile("" ::: "memory"); }
        }
    }
}

__device__ __forceinline__ void fcum_items(const Args& a, LAS unsigned char* lds, int tid, int lane, int wave, int G) {
    const float* LOGF = (const float*)(a.ws + WS_LOGF); float* FCUM = (float*)(a.ws + WS_FCUM);
    LAS float* wt = (LAS float*)(lds + 16384);
    for (int bh = blockIdx.x; bh < 64; bh += G) {
        f32x4 v = ((const f32x4*)(LOGF + (size_t)bh * SEQ))[tid];
        v.y += v.x; v.z += v.y; v.w += v.z; const float tot = v.w;
        float sc = tot;
#pragma unroll
        for (int o = 1; o < 64; o <<= 1) { const float t = __shfl_up(sc, o); if (lane >= o) sc += t; }
        __syncthreads();
        if (lane == 63) wt[wave] = sc;
        __syncthreads();
        float base = 0.f; for (int w = 0; w < wave; ++w) base += wt[w];
        const float excl = base + sc - tot;
        v.x += excl; v.y += excl; v.z += excl; v.w += excl;
        ((f32x4*)(FCUM + (size_t)bh * SEQ))[tid] = v;
    }
    __syncthreads();
}

__device__ __forceinline__ void ph4_attn_naive(const Args& a, LAS unsigned char* lds, int tid, int lane, int wave, int G) {
    const bf16* PROJ = (const bf16*)(a.ws + WS_PROJ); const float* KMEAN = (const float*)(a.ws + WS_KMEAN); const float* FCUM = (const float*)(a.ws + WS_FCUM);
    bf16* MIX = (bf16*)(a.ws + WS_MIX);
    LAS bf16* Ks = (LAS bf16*)lds; LAS bf16* Vs = (LAS bf16*)(lds + 16384); LAS float* Fs = (LAS float*)(lds + 32768);
    const int qi = tid >> 3, dg = tid & 7;
    const float scale = 0.08838834764831845f;
    for (int it = blockIdx.x; it < 4096; it += G) {
        const int qt = 31 - (it >> 7), rest = it & 127; const bool moba = rest < 64; const int bh = rest & 63, b = bh >> 4, h = bh & 15;
        const int t = qt * 64 + qi, qblk = qt >> 2;
        const int qc = moba ? 0 : 6144, kc = moba ? 2048 : 8192, vc = moba ? 4096 : 10240;
        float q[16];
        { const v4u* qp = (const v4u*)(PROJ + (size_t)(b * SEQ + t) * NQKV + qc + h * 128 + dg * 16); const v4u w0 = qp[0], w1 = qp[1];
          q[0] = bf_lo(w0.x); q[1] = bf_hi(w0.x); q[2] = bf_lo(w0.y); q[3] = bf_hi(w0.y); q[4] = bf_lo(w0.z); q[5] = bf_hi(w0.z); q[6] = bf_lo(w0.w); q[7] = bf_hi(w0.w);
          q[8] = bf_lo(w1.x); q[9] = bf_hi(w1.x); q[10] = bf_lo(w1.y); q[11] = bf_hi(w1.y); q[12] = bf_lo(w1.z); q[13] = bf_hi(w1.z); q[14] = bf_lo(w1.w); q[15] = bf_hi(w1.w);
#pragma unroll
          for (int i = 0; i < 16; ++i) q[i] *= scale; }
        unsigned selmask = 0u;
        if (moba) {
            float gate[8];
#pragma unroll
            for (int n = 0; n < 8; ++n) { float d = 0.f;
                if (n < qblk) { const float* km = KMEAN + ((size_t)bh * 8 + n) * 128 + dg * 16;
#pragma unroll
                    for (int i = 0; i < 16; ++i) d += q[i] * km[i]; }
                d += __shfl_xor(d, 1); d += __shfl_xor(d, 2); d += __shfl_xor(d, 4);
                gate[n] = (n < qblk) ? d : -1e30f; }
            if (qblk <= 3) selmask = (1u << qblk) - 1u;
            else {
#pragma unroll
                for (int r = 0; r < 3; ++r) { float bv = -3e38f; int bi = 0;
#pragma unroll
                    for (int n = 0; n < 8; ++n) if (gate[n] > bv) { bv = gate[n]; bi = n; }
                    selmask |= 1u << bi;
#pragma unroll
                    for (int n = 0; n < 8; ++n) if (n == bi) gate[n] = -3e38f; }
            }
        }
        float mx = -1e30f, l = 0.f, o[16];
#pragma unroll
        for (int i = 0; i < 16; ++i) o[i] = 0.f;
        const float slope = exp2f(-0.5f * (float)(h + 1));
        const float Ft = moba ? 0.f : FCUM[(size_t)bh * SEQ + t];
        for (int kt = 0; kt <= qt; ++kt) {
            const int blk = kt >> 2;
            __syncthreads();
            for (int i = tid; i < 1024; i += NTHR) { const int key = i >> 4, ch = i & 15; const size_t g = (size_t)(b * SEQ + kt * 64 + key) * NQKV + h * 128 + ch * 8;
                ((LAS v4u*)Ks)[i] = *(const v4u*)(PROJ + g + kc); ((LAS v4u*)Vs)[i] = *(const v4u*)(PROJ + g + vc); }
            if (!moba && tid < 64) Fs[tid] = FCUM[(size_t)bh * SEQ + kt * 64 + tid];
            __syncthreads();
            const bool need = moba ? ((blk == qblk) || ((selmask >> blk) & 1u)) : true;
            if (__any(need)) {
                for (int j = 0; j < 64; ++j) {
                    const int s = kt * 64 + j;
                    const LAS v4u* kp = (const LAS v4u*)(Ks + j * 128 + dg * 16); const v4u k0 = kp[0], k1 = kp[1];
                    float d = q[0] * bf_lo(k0.x) + q[1] * bf_hi(k0.x) + q[2] * bf_lo(k0.y) + q[3] * bf_hi(k0.y) + q[4] * bf_lo(k0.z) + q[5] * bf_hi(k0.z) + q[6] * bf_lo(k0.w) + q[7] * bf_hi(k0.w)
                            + q[8] * bf_lo(k1.x) + q[9] * bf_hi(k1.x) + q[10] * bf_lo(k1.y) + q[11] * bf_hi(k1.y) + q[12] * bf_lo(k1.z) + q[13] * bf_hi(k1.z) + q[14] * bf_lo(k1.w) + q[15] * bf_hi(k1.w);
                    d += __shfl_xor(d, 1); d += __shfl_xor(d, 2); d += __shfl_xor(d, 4);
                    const bool valid = need && (s <= t);
                    const float logit = moba ? d - slope * (float)(t - s) : d + Ft - Fs[j];
                    if (valid) {
                        if (logit > mx) { const float al = __expf(mx - logit); l *= al;
#pragma unroll
                            for (int i = 0; i < 16; ++i) o[i] *= al;
                            mx = logit; }
                        const float p = __expf(logit - mx); l += p;
                        const LAS v4u* vp = (const LAS v4u*)(Vs + j * 128 + dg * 16); const v4u v0 = vp[0], v1 = vp[1];
                        o[0] += p * bf_lo(v0.x); o[1] += p * bf_hi(v0.x); o[2] += p * bf_lo(v0.y); o[3] += p * bf_hi(v0.y); o[4] += p * bf_lo(v0.z); o[5] += p * bf_hi(v0.z); o[6] += p * bf_lo(v0.w); o[7] += p * bf_hi(v0.w);
                        o[8] += p * bf_lo(v1.x); o[9] += p * bf_hi(v1.x); o[10] += p * bf_lo(v1.y); o[11] += p * bf_hi(v1.y); o[12] += p * bf_lo(v1.z); o[13] += p * bf_hi(v1.z); o[14] += p * bf_lo(v1.w); o[15] += p * bf_hi(v1.w);
                    }
                }
            }
        }
        const float inv = 1.f / l;
        v4u o0, o1; o0.x = pk2(o[0] * inv, o[1] * inv); o0.y = pk2(o[2] * inv, o[3] * inv); o0.z = pk2(o[4] * inv, o[5] * inv); o0.w = pk2(o[6] * inv, o[7] * inv);
        o1.x = pk2(o[8] * inv, o[9] * inv); o1.y = pk2(o[10] * inv, o[11] * inv); o1.z = pk2(o[12] * inv, o[13] * inv); o1.w = pk2(o[14] * inv, o[15] * inv);
        v4u* op = (v4u*)(MIX + (size_t)(b * SEQ + t) * DM + (moba ? 0 : 2048) + h * 128 + dg * 16); op[0] = o0; op[1] = o1;
    }
}

typedef float f32x16 __attribute__((ext_vector_type(16)));
typedef short s16x4 __attribute__((ext_vector_type(4)));
constexpr int AT_KSTR = 272, AT_VSTR = 320;
constexpr int AT_K0 = 0, AT_KB = 64 * AT_KSTR, AT_V0 = 2 * AT_KB, AT_VB = 64 * AT_VSTR, AT_B0 = AT_V0 + 2 * AT_VB, AT_BB = 256;
__device__ __forceinline__ s16x4 at_vtr(const LAS unsigned char* p) { return __builtin_bit_cast(s16x4, __builtin_amdgcn_ds_read_tr16_b64_v4i16((LAS s16x4*)p)); }
__device__ __forceinline__ unsigned at_cvtpk(float lo, float hi) { unsigned r; asm("v_cvt_pk_bf16_f32 %0, %1, %2" : "=v"(r) : "v"(lo), "v"(hi)); return r; }

__device__ __forceinline__ void ph4_attn_mfma(const Args& a, LAS unsigned char* lds, int tid, int lane, int wave, int G) {
    const bf16* PROJ = (const bf16*)(a.ws + WS_PROJ); const float* KMEAN = (const float*)(a.ws + WS_KMEAN); const float* FCUM = (const float*)(a.ws + WS_FCUM);
    bf16* MIX = (bf16*)(a.ws + WS_MIX);
    const int q32 = lane & 31, hi = lane >> 5;
    const float C1 = 0.08838834764831845f * 1.4426950408889634f, LOG2E = 1.4426950408889634f;
    const int vlane = (4 * hi + ((lane & 15) >> 2)) * AT_VSTR + (16 * ((lane >> 4) & 1) + 4 * (lane & 3)) * 2;
    const int klane = q32 * AT_KSTR + hi * 16;
    for (int pi = blockIdx.x; pi < 512; pi += G) {
      for (int half = 0; half < 2; ++half) {
        const int khb = pi >> 2, jq = pi & 3;
        const int qb = half == 0 ? 7 - jq : jq;
        const bool moba = khb < 64; const int bh = khb & 63, b = bh >> 4, h = bh & 15;
        const int qc = moba ? 0 : 6144, kc = moba ? 2048 : 8192, vc = moba ? 4096 : 10240;
        const int t0 = qb * 256, tw = t0 + 32 * wave;
        const bf16* pbase = PROJ + (size_t)(b * SEQ) * NQKV + h * 128;
        v4u qf[8];
        { const bf16* qp = pbase + (size_t)(tw + q32) * NQKV + qc + 8 * hi;
#pragma unroll
          for (int ks = 0; ks < 8; ++ks) qf[ks] = *(const v4u*)(qp + 16 * ks); }
        unsigned selmask = 0u;
        if (moba && qb > 0) {
            float gate[8];
#pragma unroll
            for (int n = 0; n < 8; ++n) { float d = 0.f;
                if (n < qb) { const float* km = KMEAN + ((size_t)bh * 8 + n) * 128 + 8 * hi;
#pragma unroll
                    for (int ks = 0; ks < 8; ++ks) { const f32x4 k0 = *(const f32x4*)(km + 16 * ks), k1 = *(const f32x4*)(km + 16 * ks + 4); const v4u w = qf[ks];
                        d += bf_lo(w.x) * k0.x + bf_hi(w.x) * k0.y + bf_lo(w.y) * k0.z + bf_hi(w.y) * k0.w + bf_lo(w.z) * k1.x + bf_hi(w.z) * k1.y + bf_lo(w.w) * k1.z + bf_hi(w.w) * k1.w; } }
                d += __shfl_xor(d, 32);
                gate[n] = (n < qb) ? d : -1e30f; }
            if (qb <= 3) selmask = (1u << qb) - 1u;
            else {
#pragma unroll
                for (int r = 0; r < 3; ++r) { float bv = -3e38f; int bi = 0;
#pragma unroll
                    for (int n = 0; n < 8; ++n) if (gate[n] > bv) { bv = gate[n]; bi = n; }
                    selmask |= 1u << bi;
#pragma unroll
                    for (int n = 0; n < 8; ++n) if (n == bi) gate[n] = -3e38f; }
            }
        }
        const float slope2 = exp2f(-0.5f * (float)(h + 1)) * LOG2E;
        const float Fref = moba ? 0.f : FCUM[(size_t)bh * SEQ + t0];
        float mrow = -1e30f, lrow = 0.f;
        f32x16 o[4];
#pragma unroll
        for (int db = 0; db < 4; ++db)
#pragma unroll
            for (int r = 0; r < 16; ++r) o[db][r] = 0.f;
        const int ntiles = 4 * (qb + 1);
        v4u sk0 = {0u, 0u, 0u, 0u}, sk1 = sk0, sv0 = sk0, sv1 = sk0, tk0 = sk0, tk1 = sk0, tv0 = sk0, tv1 = sk0; float sbias = 0.f, tbias = 0.f;
        const int skey0 = tid >> 4, sch = tid & 15;
#define AT_ISSUE(idx_, K0_, K1_, V0_, V1_, B_) do { const int bp_ = (idx_) >> 2, ti_ = (idx_) & 3; const int kb_ = bp_ == 0 ? qb : bp_ - 1; const int key0_ = kb_ * 256 + ti_ * 64; \
            const bf16* g0_ = pbase + (size_t)(key0_ + skey0) * NQKV + sch * 8; const bf16* g1_ = g0_ + (size_t)32 * NQKV; \
            K0_ = *(const v4u*)(g0_ + kc); K1_ = *(const v4u*)(g1_ + kc); V0_ = *(const v4u*)(g0_ + vc); V1_ = *(const v4u*)(g1_ + vc); \
            (void)B_; } while (0)
#define AT_WRITE(idx_, K0_, K1_, V0_, V1_, B_) do { const int bf_ = (idx_) & 1; \
            *(LAS v4u*)(lds + AT_K0 + bf_ * AT_KB + skey0 * AT_KSTR + sch * 16) = K0_; *(LAS v4u*)(lds + AT_K0 + bf_ * AT_KB + (skey0 + 32) * AT_KSTR + sch * 16) = K1_; \
            *(LAS v4u*)(lds + AT_V0 + bf_ * AT_VB + skey0 * AT_VSTR + sch * 16) = V0_; *(LAS v4u*)(lds + AT_V0 + bf_ * AT_VB + (skey0 + 32) * AT_VSTR + sch * 16) = V1_; \
            (void)B_; } while (0)
#define AT_SET_S sk0, sk1, sv0, sv1, sbias
#define AT_SET_T tk0, tk1, tv0, tv1, tbias
#define AT_ISSUE_(i_, ...) AT_ISSUE(i_, __VA_ARGS__)
#define AT_WRITE_(i_, ...) AT_WRITE(i_, __VA_ARGS__)
#define AT_BAR() do { asm volatile("s_waitcnt lgkmcnt(0)" ::: "memory"); __builtin_amdgcn_s_barrier(); asm volatile("" ::: "memory"); } while (0)
        for (int s_ = tid; s_ < (qb + 1) * 256; s_ += NTHR) *(LAS float*)(lds + AT_B0 + s_ * 4) = moba ? slope2 * (float)(s_ - t0) : (Fref - FCUM[(size_t)bh * SEQ + s_]) * LOG2E;
        AT_ISSUE_(0, AT_SET_S); AT_WRITE_(0, AT_SET_S);
        AT_ISSUE_(1, AT_SET_S);
        asm volatile("s_waitcnt lgkmcnt(0)" ::: "memory"); __syncthreads();
        for (int idx2 = 0; idx2 < ntiles; idx2 += 2) {
            { const int idx = idx2;
              if (idx + 2 < ntiles) AT_ISSUE_(idx + 2, AT_SET_T);
            const int bp = idx >> 2, ti = idx & 3; const bool own = bp == 0; const int kb = own ? qb : bp - 1;
            const bool lane_sel = own || !moba || ((selmask >> kb) & 1u);
            const bool active = own ? (ti <= (wave >> 1)) : (__any(lane_sel) != 0);
            if (active) {
                const int bf = idx & 1;
                f32x16 s0, s1;
#pragma unroll
                for (int r = 0; r < 16; ++r) { s0[r] = 0.f; s1[r] = 0.f; }
                const LAS unsigned char* Kb = lds + AT_K0 + bf * AT_KB + klane;
#pragma unroll
                for (int ks = 0; ks < 8; ++ks) {
                    const bf16x8 k0 = *(const LAS bf16x8*)(Kb + ks * 32), k1 = *(const LAS bf16x8*)(Kb + 32 * AT_KSTR + ks * 32);
                    const bf16x8 qv = __builtin_bit_cast(bf16x8, qf[ks]);
                    s0 = __builtin_amdgcn_mfma_f32_32x32x16_bf16(k0, qv, s0, 0, 0, 0);
                    s1 = __builtin_amdgcn_mfma_f32_32x32x16_bf16(k1, qv, s1, 0, 0, 0);
                }
                const LAS float* Bb = (const LAS float*)(lds + AT_B0) + kb * 256 + ti * 64 + 4 * hi;
                const float lb = lane_sel ? 0.f : -1e30f;
                float t[32];
#pragma unroll
                for (int g = 0; g < 4; ++g) { const f32x4 b0 = *(const LAS f32x4*)(Bb + 8 * g), b1 = *(const LAS f32x4*)(Bb + 32 + 8 * g);
#pragma unroll
                    for (int r = 0; r < 4; ++r) { t[4 * g + r] = fmaf(s0[4 * g + r], C1, b0[r] + lb); t[16 + 4 * g + r] = fmaf(s1[4 * g + r], C1, b1[r] + lb); } }
                if (own && ti == (wave >> 1)) {
                    const int rloc = 32 * (wave & 1) + q32 - 4 * hi;
#pragma unroll
                    for (int r = 0; r < 16; ++r) { const int kk = (r & 3) + 8 * (r >> 2);
                        t[r] = (kk > rloc) ? -1e30f : t[r]; t[16 + r] = (32 + kk > rloc) ? -1e30f : t[16 + r]; }
                }
                float mx = t[0];
#pragma unroll
                for (int i = 1; i < 32; ++i) mx = fmaxf(mx, t[i]);
                mx = fmaxf(mx, __shfl_xor(mx, 32));
                const float mnew = fmaxf(mrow, mx);
                const float alpha = __builtin_amdgcn_exp2f(mrow - mnew);
                mrow = mnew;
                float psum = 0.f;
#pragma unroll
                for (int i = 0; i < 32; ++i) { t[i] = __builtin_amdgcn_exp2f(t[i] - mnew); psum += t[i]; }
                lrow = lrow * alpha + psum;
                unsigned pk[16];
#pragma unroll
                for (int d = 0; d < 16; ++d) pk[d] = at_cvtpk(t[2 * d], t[2 * d + 1]);
                if (!__all(alpha == 1.0f)) {
#pragma unroll
                    for (int db = 0; db < 4; ++db)
#pragma unroll
                        for (int r = 0; r < 16; ++r) o[db][r] *= alpha;
                }
                const LAS unsigned char* Vb = lds + AT_V0 + bf * AT_VB + vlane;
#pragma unroll
                for (int kk = 0; kk < 4; ++kk) {
                    v4u pw; pw.x = pk[4 * kk + 0]; pw.y = pk[4 * kk + 1]; pw.z = pk[4 * kk + 2]; pw.w = pk[4 * kk + 3];
                    const bf16x8 pb = __builtin_bit_cast(bf16x8, pw);
#pragma unroll
                    for (int db = 0; db < 4; ++db) {
                        const s16x4 lo = at_vtr(Vb + (16 * kk) * AT_VSTR + 64 * db), hi4 = at_vtr(Vb + (16 * kk + 8) * AT_VSTR + 64 * db);
                        bf16x8 va; va[0] = lo[0]; va[1] = lo[1]; va[2] = lo[2]; va[3] = lo[3]; va[4] = hi4[0]; va[5] = hi4[1]; va[6] = hi4[2]; va[7] = hi4[3];
                        o[db] = __builtin_amdgcn_mfma_f32_32x32x16_bf16(va, pb, o[db], 0, 0, 0);
                    }
                }
            }
              if (idx + 1 < ntiles) AT_WRITE_(idx + 1, AT_SET_S);
              AT_BAR(); }
            { const int idx = idx2 + 1;
              if (idx + 2 < ntiles) AT_ISSUE_(idx + 2, AT_SET_S);
            const int bp = idx >> 2, ti = idx & 3; const bool own = bp == 0; const int kb = own ? qb : bp - 1;
            const bool lane_sel = own || !moba || ((selmask >> kb) & 1u);
            const bool active = own ? (ti <= (wave >> 1)) : (__any(lane_sel) != 0);
            if (active) {
                const int bf = idx & 1;
                f32x16 s0, s1;
#pragma unroll
                for (int r = 0; r < 16; ++r) { s0[r] = 0.f; s1[r] = 0.f; }
                const LAS unsigned char* Kb = lds + AT_K0 + bf * AT_KB + klane;
#pragma unroll
                for (int ks = 0; ks < 8; ++ks) {
                    const bf16x8 k0 = *(const LAS bf16x8*)(Kb + ks * 32), k1 = *(const LAS bf16x8*)(Kb + 32 * AT_KSTR + ks * 32);
                    const bf16x8 qv = __builtin_bit_cast(bf16x8, qf[ks]);
                    s0 = __builtin_amdgcn_mfma_f32_32x32x16_bf16(k0, qv, s0, 0, 0, 0);
                    s1 = __builtin_amdgcn_mfma_f32_32x32x16_bf16(k1, qv, s1, 0, 0, 0);
                }
                const LAS float* Bb = (const LAS float*)(lds + AT_B0) + kb * 256 + ti * 64 + 4 * hi;
                const float lb = lane_sel ? 0.f : -1e30f;
                float t[32];
#pragma unroll
                for (int g = 0; g < 4; ++g) { const f32x4 b0 = *(const LAS f32x4*)(Bb + 8 * g), b1 = *(const LAS f32x4*)(Bb + 32 + 8 * g);
#pragma unroll
                    for (int r = 0; r < 4; ++r) { t[4 * g + r] = fmaf(s0[4 * g + r], C1, b0[r] + lb); t[16 + 4 * g + r] = fmaf(s1[4 * g + r], C1, b1[r] + lb); } }
                if (own && ti == (wave >> 1)) {
                    const int rloc = 32 * (wave & 1) + q32 - 4 * hi;
#pragma unroll
                    for (int r = 0; r < 16; ++r) { const int kk = (r & 3) + 8 * (r >> 2);
                        t[r] = (kk > rloc) ? -1e30f : t[r]; t[16 + r] = (32 + kk > rloc) ? -1e30f : t[16 + r]; }
                }
                float mx = t[0];
#pragma unroll
                for (int i = 1; i < 32; ++i) mx = fmaxf(mx, t[i]);
                mx = fmaxf(mx, __shfl_xor(mx, 32));
                const float mnew = fmaxf(mrow, mx);
                const float alpha = __builtin_amdgcn_exp2f(mrow - mnew);
                mrow = mnew;
                float psum = 0.f;
#pragma unroll
                for (int i = 0; i < 32; ++i) { t[i] = __builtin_amdgcn_exp2f(t[i] - mnew); psum += t[i]; }
                lrow = lrow * alpha + psum;
                unsigned pk[16];
#pragma unroll
                for (int d = 0; d < 16; ++d) pk[d] = at_cvtpk(t[2 * d], t[2 * d + 1]);
                if (!__all(alpha == 1.0f)) {
#pragma unroll
                    for (int db = 0; db < 4; ++db)
#pragma unroll
                        for (int r = 0; r < 16; ++r) o[db][r] *= alpha;
                }
                const LAS unsigned char* Vb = lds + AT_V0 + bf * AT_VB + vlane;
#pragma unroll
                for (int kk = 0; kk < 4; ++kk) {
                    v4u pw; pw.x = pk[4 * kk + 0]; pw.y = pk[4 * kk + 1]; pw.z = pk[4 * kk + 2]; pw.w = pk[4 * kk + 3];
                    const bf16x8 pb = __builtin_bit_cast(bf16x8, pw);
#pragma unroll
                    for (int db = 0; db < 4; ++db) {
                        const s16x4 lo = at_vtr(Vb + (16 * kk) * AT_VSTR + 64 * db), hi4 = at_vtr(Vb + (16 * kk + 8) * AT_VSTR + 64 * db);
                        bf16x8 va; va[0] = lo[0]; va[1] = lo[1]; va[2] = lo[2]; va[3] = lo[3]; va[4] = hi4[0]; va[5] = hi4[1]; va[6] = hi4[2]; va[7] = hi4[3];
                        o[db] = __builtin_amdgcn_mfma_f32_32x32x16_bf16(va, pb, o[db], 0, 0, 0);
                    }
                }
            }
              if (idx + 1 < ntiles) AT_WRITE_(idx + 1, AT_SET_T);
              AT_BAR(); }
        }
        __syncthreads();
#undef AT_ISSUE
#undef AT_WRITE
        const float ltot = lrow + __shfl_xor(lrow, 32);
        const float inv = 1.f / ltot;
        bf16* op = MIX + (size_t)(b * SEQ + tw + q32) * DM + (moba ? 0 : 2048) + h * 128 + 4 * hi;
#pragma unroll
        for (int db = 0; db < 4; ++db)
#pragma unroll
            for (int g = 0; g < 4; ++g) { v2u w; w.x = pk2(o[db][4 * g + 0] * inv, o[db][4 * g + 1] * inv); w.y = pk2(o[db][4 * g + 2] * inv, o[db][4 * g + 3] * inv);
                *(v2u*)(op + 32 * db + 8 * g) = w; }
      }
    }
}

__device__ __forceinline__ void ph_requant_mix(const Args& a, int lane, int wave, int G) {
    const bf16* MIX = (const bf16*)(a.ws + WS_MIX); unsigned char* MIXQ = a.ws + WS_MIXQ; float* MSC = (float*)(a.ws + WS_MSC); const float* sko = (const float*)(a.ws + WS_SKOF);
    const int gw = blockIdx.x * NWAVES + wave, NGW = G * NWAVES;
    for (int m = gw; m < NTOK; m += NGW) {
        const v4u* src = (const v4u*)(MIX + (size_t)m * DM) + lane;
        float f[8][8]; float mx = 0.f;
#pragma unroll
        for (int j = 0; j < 8; ++j) { const v4u w = src[64 * j]; const f32x4 s0 = *(const f32x4*)(sko + 8 * lane + 512 * j), s1 = *(const f32x4*)(sko + 8 * lane + 512 * j + 4);
            f[j][0] = bf_lo(w.x) * s0.x; f[j][1] = bf_hi(w.x) * s0.y; f[j][2] = bf_lo(w.y) * s0.z; f[j][3] = bf_hi(w.y) * s0.w;
            f[j][4] = bf_lo(w.z) * s1.x; f[j][5] = bf_hi(w.z) * s1.y; f[j][6] = bf_lo(w.w) * s1.z; f[j][7] = bf_hi(w.w) * s1.w;
#pragma unroll
            for (int e = 0; e < 8; ++e) mx = fmaxf(mx, fabsf(f[j][e])); }
#pragma unroll
        for (int o = 1; o < 64; o <<= 1) mx = fmaxf(mx, __shfl_xor(mx, o));
        const float qs = mx > 0.f ? mx * (1.f / 127.f) : 1.f, qi = 1.f / qs;
        if (lane == 0) MSC[m] = qs;
        v2u* dst = (v2u*)(MIXQ + (size_t)m * DM) + lane;
#pragma unroll
        for (int j = 0; j < 8; ++j) { int q[8];
#pragma unroll
            for (int e = 0; e < 8; ++e) q[e] = __float2int_rn(f[j][e] * qi);
            v2u o; o.x = ((unsigned)q[0] & 255u) | (((unsigned)q[1] & 255u) << 8) | (((unsigned)q[2] & 255u) << 16) | (((unsigned)q[3] & 255u) << 24);
            o.y = ((unsigned)q[4] & 255u) | (((unsigned)q[5] & 255u) << 8) | (((unsigned)q[6] & 255u) << 16) | (((unsigned)q[7] & 255u) << 24);
            dst[64 * j] = o; }
    }
}

__device__ __forceinline__ void ph8_select(const Args& a, LAS unsigned char* lds, int tid, int lane, int wave, int G) {
    const bf16* QP = (const bf16*)(a.ws + WS_QP); const bf16* SKB = (const bf16*)(a.ws + WS_SKB);
    int* EIDX = (int*)(a.ws + WS_EIDX); float* GATE = (float*)(a.ws + WS_GATE);
    LAS float* sc = (LAS float*)(lds + wave * 18944);
    LAS int* lst = (LAS int*)(lds + wave * 18944 + 16896);
    const int h = wave;
    const float* Vf = a.in[16]; float* vscp = (float*)(a.ws + WS_VSC);
    f32x4 cv[16];
#define P8_VISSUE(e_) do { const f32x4* sp_ = (const f32x4*)(Vf + (size_t)(e_) * DM) + lane; _Pragma("unroll") for (int j_ = 0; j_ < 16; ++j_) cv[j_] = sp_[64 * j_]; asm volatile("" ::: "memory"); } while (0)
#define P8_VFINISH(e_) do { float mx_ = 0.f; \
        _Pragma("unroll") for (int j_ = 0; j_ < 16; ++j_) mx_ = fmaxf(mx_, fmaxf(fmaxf(fabsf(cv[j_].x), fabsf(cv[j_].y)), fmaxf(fabsf(cv[j_].z), fabsf(cv[j_].w)))); \
        _Pragma("unroll") for (int o_ = 1; o_ < 64; o_ <<= 1) mx_ = fmaxf(mx_, __shfl_xor(mx_, o_)); \
        const float sc_ = mx_ > 0.f ? mx_ * (1.f / 127.f) : 1.f, inv_ = 1.f / sc_; \
        if (lane == 0) vscp[(e_)] = sc_; \
        unsigned char* dst_ = a.ws + WS_VB + (size_t)(e_) * 128 + ((4 * lane) & 127); \
        _Pragma("unroll") for (int j_ = 0; j_ < 16; ++j_) { \
            const int q0_ = __float2int_rn(cv[j_].x * inv_), q1_ = __float2int_rn(cv[j_].y * inv_), q2_ = __float2int_rn(cv[j_].z * inv_), q3_ = __float2int_rn(cv[j_].w * inv_); \
            *(unsigned*)(dst_ + (size_t)(2 * j_ + (lane >> 5)) * (16384 * 128)) = ((unsigned)q0_ & 255u) | (((unsigned)q1_ & 255u) << 8) | (((unsigned)q2_ & 255u) << 16) | (((unsigned)q3_ & 255u) << 24); } } while (0)
    for (int it = blockIdx.x; it < NTOK / 16; it += G) {
        const int t0 = it * 16; const int ev0 = 4 * (8 * it + wave);
        P8_VISSUE(ev0);
#pragma unroll
        for (int c = 0; c < 2; ++c) {
            bf16x8 A[4];
#pragma unroll
            for (int ks = 0; ks < 4; ++ks) A[ks] = *(const bf16x8*)(QP + (size_t)(t0 + (lane & 15)) * PQ + h * 256 + c * 128 + ks * 32 + (lane >> 4) * 8);
#pragma unroll
            for (int ng = 0; ng < 2; ++ng) {
                bf16x8 Bf[4][4];
#pragma unroll
                for (int n4 = 0; n4 < 4; ++n4)
#pragma unroll
                    for (int ks = 0; ks < 4; ++ks) Bf[n4][ks] = *(const bf16x8*)(SKB + (size_t)((h * 2 + c) * 128 + (4 * ng + n4) * 16 + (lane & 15)) * 128 + ks * 32 + (lane >> 4) * 8);
#pragma unroll
                for (int n4 = 0; n4 < 4; ++n4) { const int nt = 4 * ng + n4; f32x4 acc = {0.f, 0.f, 0.f, 0.f};
#pragma unroll
                    for (int ks = 0; ks < 4; ++ks) acc = __builtin_amdgcn_mfma_f32_16x16x32_bf16(A[ks], Bf[n4][ks], acc, 0, 0, 0);
#pragma unroll
                    for (int i = 0; i < 4; ++i) sc[(c * 16 + (lane >> 4) * 4 + i) * 132 + nt * 16 + (lane & 15)] = acc[i]; }
            }
        }
        P8_VFINISH(ev0); P8_VISSUE(ev0 + 1);
        LDS_WAIT();
        {
            const int row = lane & 31, hh = lane >> 5;
            int L[16];
#pragma unroll
            for (int k = 0; k < 16; ++k) L[k] = (int)0x80000000;
            const LAS f32x4* rp = (const LAS f32x4*)(sc + row * 132 + 64 * hh);
            for (int i = 0; i < 16; ++i) {
                const f32x4 v = rp[i];
#pragma unroll
                for (int e = 0; e < 4; ++e) { int x = tokey((__float_as_uint(v[e]) & ~127u) | (unsigned)(64 * hh + i * 4 + e));
#pragma unroll
                    for (int k = 0; k < 16; ++k) { const int hi = max(L[k], x); x = min(L[k], x); L[k] = hi; } }
            }
            if (hh == 1) {
#pragma unroll
                for (int k = 0; k < 16; ++k) lst[row * 16 + k] = L[k];
            }
            P8_VFINISH(ev0 + 1); P8_VISSUE(ev0 + 2);
            LDS_WAIT();
            if (hh == 0) {
#pragma unroll
                for (int q = 0; q < 16; ++q) { int x = lst[row * 16 + q];
#pragma unroll
                    for (int k = 0; k < 16; ++k) { const int hi = max(L[k], x); x = min(L[k], x); L[k] = hi; } }
            }
            LDS_WAIT();
            if (hh == 0) {
#pragma unroll
                for (int k = 0; k < 16; ++k) lst[row * 16 + k] = L[k];
            }
        }
        P8_VFINISH(ev0 + 2); P8_VISSUE(ev0 + 3);
        LDS_WAIT();
        if (lane < 16) {
            float va[16], vb[16];
#pragma unroll
            for (int i = 0; i < 16; ++i) { const unsigned ia = unkey(lst[lane * 16 + i]) & 127u, ib = unkey(lst[(16 + lane) * 16 + i]) & 127u;
                va[i] = sc[lane * 132 + ia]; vb[i] = sc[(16 + lane) * 132 + ib]; }
            int L2[16];
#pragma unroll
            for (int k = 0; k < 16; ++k) L2[k] = (int)0x80000000;
#pragma unroll
            for (int i = 0; i < 16; ++i)
#pragma unroll
                for (int j = 0; j < 16; ++j)
                    if ((i + 1) * (j + 1) <= 16) { int x = tokey((__float_as_uint(va[i] + vb[j]) & ~255u) | (unsigned)(i * 16 + j));
#pragma unroll
                        for (int k = 0; k < 16; ++k) { const int hi = max(L2[k], x); x = min(L2[k], x); L2[k] = hi; } }
            float sv[16]; int ev[16]; float mxv = -3e38f;
#pragma unroll
            for (int k = 0; k < 16; ++k) { const unsigned code = unkey(L2[k]) & 255u; const int i = code >> 4, j = code & 15;
                const unsigned ea = unkey(lst[lane * 16 + i]) & 127u, eb = unkey(lst[(16 + lane) * 16 + j]) & 127u;
                const float s = sc[lane * 132 + ea] + sc[(16 + lane) * 132 + eb]; sv[k] = s; ev[k] = (int)(ea * 128u + eb); mxv = fmaxf(mxv, s); }
            float sum = 0.f;
#pragma unroll
            for (int k = 0; k < 16; ++k) { sv[k] = __expf(sv[k] - mxv); sum += sv[k]; }
            const float inv = 1.f / sum;
            int* ep = EIDX + (size_t)(t0 + lane) * 128 + h * 16; float* gp = GATE + (size_t)(t0 + lane) * 128 + h * 16;
#pragma unroll
            for (int k = 0; k < 16; ++k) { ep[k] = ev[k]; gp[k] = sv[k] * inv; }
        }
        P8_VFINISH(ev0 + 3);
        LDS_WAIT();
    }
#undef P8_VISSUE
#undef P8_VFINISH
}

__device__ __forceinline__ float gelu_exact(float x) { return 0.5f * x * (1.f + erff(x * 0.70710678118654752f)); }
__device__ __forceinline__ float ub0(unsigned x) { return (float)(x & 255u); }
__device__ __forceinline__ float ub1(unsigned x) { return (float)((x >> 8) & 255u); }
__device__ __forceinline__ float ub2(unsigned x) { return (float)((x >> 16) & 255u); }
__device__ __forceinline__ float ub3(unsigned x) { return (float)(x >> 24); }
template <int CTRL> __device__ __forceinline__ int dpp_i(int v) { return __builtin_amdgcn_update_dpp(0, v, CTRL, 0xf, 0xf, false); }
__device__ __forceinline__ void ph9_gather(const Args& a, LAS unsigned char* lds, int lane, int wave, int G) {
    const unsigned char* H2Q = a.ws + WS_H2Q; const float* HSC = (const float*)(a.ws + WS_HSC); const float* USC = (const float*)(a.ws + WS_USC); const float* VSC = (const float*)(a.ws + WS_VSC);
    const int* EIDX = (const int*)(a.ws + WS_EIDX); const float* GATE = (const float*)(a.ws + WS_GATE);
    const unsigned char* UB = a.ws + WS_UB; const unsigned char* VB = a.ws + WS_VB; const float* mod = (const float*)(a.ws + WS_MOD);
    const int p = lane >> 3, s = lane & 7; const unsigned s16 = (unsigned)s * 16u;
    LAS unsigned* offl = (LAS unsigned*)(lds + wave * 4096) + p;
    LAS float* wl = (LAS float*)(lds + wave * 4096 + 2048) + p;
    const __amdgpu_buffer_rsrc_t rsu = __builtin_amdgcn_make_buffer_rsrc((void*)UB, (short)0, 32 * 16384 * 128, 0x00020000);
    const __amdgpu_buffer_rsrc_t rsv = __builtin_amdgcn_make_buffer_rsrc((void*)VB, (short)0, 32 * 16384 * 128, 0x00020000);
    for (int tg = blockIdx.x; tg < NTOK / 32; tg += G) {
        const int tb = tg * 32 + wave * 4, b = tb / SEQ;
        if (s == 0) { int pl = p; asm volatile("" : "+v"(pl));
#pragma unroll
            for (int tk = 0; tk < 4; ++tk)
#pragma unroll
                for (int i = 0; i < 16; ++i) offl[(tk * 16 + i) * 8] = (unsigned)EIDX[(size_t)(tb + tk) * 128 + 8 * i + pl] * 128u;
        }
        LDS_WAIT();
        int acc[4][16];
#pragma unroll
        for (int tk = 0; tk < 4; ++tk)
#pragma unroll
            for (int i = 0; i < 16; ++i) acc[tk][i] = 0;
#ifndef P9_DUPU
#define P9_DUPU 1
#endif
#ifndef P9_DUPV
#define P9_DUPV 1
#endif
        { v4u uA[16], uB[16], hA, hB;
#define P9_ULOAD(R, HPV, c_, tk_) do { HPV = *(const v4u*)(H2Q + (size_t)(tb + (tk_)) * DM + (c_) * 128 + s * 16); \
            _Pragma("unroll") for (int i_ = 0; i_ < 16; ++i_) R[i_] = __builtin_amdgcn_raw_buffer_load_b128(rsu, (int)(offl[((tk_) * 16 + i_) * 8] + s16), (c_) * (16384 * 128), 0); } while (0)
#define P9_UDOT(R, HPV, tk_) do { _Pragma("unroll") for (int i_ = 0; i_ < 16; ++i_) { int d = acc[tk_][i_]; \
                d = __builtin_amdgcn_sdot4((int)R[i_].x, (int)HPV.x, d, false); d = __builtin_amdgcn_sdot4((int)R[i_].y, (int)HPV.y, d, false); \
                d = __builtin_amdgcn_sdot4((int)R[i_].z, (int)HPV.z, d, false); d = __builtin_amdgcn_sdot4((int)R[i_].w, (int)HPV.w, d, false); acc[tk_][i_] = d; } \
            asm volatile("" : "+v"(acc[tk_][0]), "+v"(acc[tk_][1]), "+v"(acc[tk_][2]), "+v"(acc[tk_][3]), "+v"(acc[tk_][4]), "+v"(acc[tk_][5]), "+v"(acc[tk_][6]), "+v"(acc[tk_][7]), \
                "+v"(acc[tk_][8]), "+v"(acc[tk_][9]), "+v"(acc[tk_][10]), "+v"(acc[tk_][11]), "+v"(acc[tk_][12]), "+v"(acc[tk_][13]), "+v"(acc[tk_][14]), "+v"(acc[tk_][15]) :: "memory"); } while (0)
          P9_ULOAD(uA, hA, 0, 0);
          for (int cc = 0; cc < 32 * P9_DUPU; ++cc) { const int c = cc & 31, cn = (cc + 1) & 31;
            P9_ULOAD(uB, hB, c, 1); P9_UDOT(uA, hA, 0);
            P9_ULOAD(uA, hA, c, 2); P9_UDOT(uB, hB, 1);
            P9_ULOAD(uB, hB, c, 3); P9_UDOT(uA, hA, 2);
            if (cc + 1 < 32 * P9_DUPU) P9_ULOAD(uA, hA, cn, 0);
            P9_UDOT(uB, hB, 3);
          }
#undef P9_ULOAD
#undef P9_UDOT
        }
        LAS unsigned* whl = (LAS unsigned*)(lds + wave * 4096 + 2048);
        float wsc[4];
#pragma unroll
        for (int tk = 0; tk < 4; ++tk) {
            const float hs = HSC[tb + tk]; float wmx = 0.f; float wv[16]; int pg = p; asm volatile("" : "+v"(pg));
#pragma unroll
            for (int i = 0; i < 16; i += 2) { int d0 = acc[tk][i], d1 = acc[tk][i + 1];
                d0 /= P9_DUPU; d1 /= P9_DUPU;
                d0 += dpp_i<0xB1>(d0); d0 += dpp_i<0x4E>(d0); d0 += dpp_i<0x141>(d0);
                d1 += dpp_i<0xB1>(d1); d1 += dpp_i<0x4E>(d1); d1 += dpp_i<0x141>(d1);
                const unsigned e0 = offl[(tk * 16 + i) * 8] >> 7, e1 = offl[(tk * 16 + i + 1) * 8] >> 7;
                const pg8::f32x2 gl = pg8::gelu_pk((pg8::f32x2){(float)d0 * (USC[e0] * hs), (float)d1 * (USC[e1] * hs)});
                const float w0 = GATE[(size_t)(tb + tk) * 128 + 8 * i + pg] * gl.x * VSC[e0], w1 = GATE[(size_t)(tb + tk) * 128 + 8 * (i + 1) + pg] * gl.y * VSC[e1];
                wv[i] = w0; wv[i + 1] = w1; wmx = fmaxf(wmx, fmaxf(fabsf(w0), fabsf(w1))); }
            wmx = fmaxf(wmx, __shfl_xor(wmx, 8)); wmx = fmaxf(wmx, __shfl_xor(wmx, 16)); wmx = fmaxf(wmx, __shfl_xor(wmx, 32));
            const float wsv = wmx > 0.f ? wmx : 1.f, qf = 16256.f / wsv; wsc[tk] = wsv * (1.f / 16256.f);
#pragma unroll
            for (int g = 0; g < 4; ++g) { unsigned ph = 0u, pl = 0u;
#pragma unroll
                for (int q = 0; q < 4; ++q) { const int W = __float2int_rn(wv[4 * g + q] * qf); const int hi = (W + 64) >> 7, lo = W - (hi << 7);
                    ph |= ((unsigned)hi & 255u) << (8 * q); pl |= ((unsigned)lo & 255u) << (8 * q); }
                if (s == 0) { whl[(tk * 4 + g) * 16 + p] = ph; whl[(tk * 4 + g) * 16 + 8 + p] = pl; } }
            asm volatile("" ::: "memory"); }
        LDS_WAIT();
        const float* g2 = mod + (size_t)b * NMOD + 5 * DM;
        LAS float* g2l = (LAS float*)(lds + 32768);
        __syncthreads();
        { const f32x4 t0 = *(const f32x4*)(g2 + 4 * (wave * 64 + lane)), t1 = *(const f32x4*)(g2 + 2048 + 4 * (wave * 64 + lane));
          *(LAS f32x4*)(g2l + 4 * (wave * 64 + lane)) = t0; *(LAS f32x4*)(g2l + 2048 + 4 * (wave * 64 + lane)) = t1; }
        __syncthreads();
        v4u rA[16], rB[16]; v4u xA, xB;
#define P9_VLOAD(R, X, c_, tk_) do { \
            X = (v4u){0u, 0u, 0u, 0u}; \
            if (p < 2) { int lo_ = s * 16 + 8 * p; asm volatile("" : "+v"(lo_)); X = *(const v4u*)((const bf16*)(a.ws + WS_H) + (size_t)(tb + (tk_)) * DM + (c_) * 128 + lo_); } \
            _Pragma("unroll") for (int i_ = 0; i_ < 16; ++i_) R[i_] = __builtin_amdgcn_raw_buffer_load_b128(rsv, (int)(offl[((tk_) * 16 + i_) * 8] + s16), (c_) * (16384 * 128), 0); } while (0)
#define P9_OUT(X, c_, tk_, J0) do { int so_ = s * 16 + (J0); asm volatile("" : "+v"(so_)); float* op = a.out + (size_t)(tb + (tk_)) * DM + (c_) * 128 + so_; \
            const f32x4 ya = {y[(J0) + 0], y[(J0) + 1], y[(J0) + 2], y[(J0) + 3]}, yb = {y[(J0) + 4], y[(J0) + 5], y[(J0) + 6], y[(J0) + 7]}; \
            const f32x4 ga_ = *(const LAS f32x4*)(g2l + (c_) * 128 + so_), gb_ = *(const LAS f32x4*)(g2l + (c_) * 128 + so_ + 4); \
            const f32x4 x0_ = {bf_lo(X.x), bf_hi(X.x), bf_lo(X.y), bf_hi(X.y)}, x1_ = {bf_lo(X.z), bf_hi(X.z), bf_lo(X.w), bf_hi(X.w)}; \
            *(f32x4*)op = x0_ + ga_ * ya; *(f32x4*)(op + 4) = x1_ + gb_ * yb; } while (0)
#define P9_VPROC(R, X, c_, tk_) do { int yh[16], yl[16]; \
            _Pragma("unroll") for (int j = 0; j < 16; ++j) { yh[j] = 0; yl[j] = 0; } \
            _Pragma("unroll") for (int g = 0; g < 4; ++g) { const int wh_ = (int)whl[((tk_) * 4 + g) * 16 + p], wl_ = (int)whl[((tk_) * 4 + g) * 16 + 8 + p]; \
                _Pragma("unroll") for (int dw = 0; dw < 4; ++dw) { const unsigned a_ = R[4 * g][dw], b_ = R[4 * g + 1][dw], c2_ = R[4 * g + 2][dw], d_ = R[4 * g + 3][dw]; \
                    const unsigned t0 = __builtin_amdgcn_perm(b_, a_, 0x05010400u), t1 = __builtin_amdgcn_perm(b_, a_, 0x07030602u), t2 = __builtin_amdgcn_perm(d_, c2_, 0x05010400u), t3 = __builtin_amdgcn_perm(d_, c2_, 0x07030602u); \
                    const int o0 = (int)__builtin_amdgcn_perm(t2, t0, 0x05040100u), o1 = (int)__builtin_amdgcn_perm(t2, t0, 0x07060302u), o2 = (int)__builtin_amdgcn_perm(t3, t1, 0x05040100u), o3 = (int)__builtin_amdgcn_perm(t3, t1, 0x07060302u); \
                    yh[4 * dw + 0] = __builtin_amdgcn_sdot4(o0, wh_, yh[4 * dw + 0], false); yl[4 * dw + 0] = __builtin_amdgcn_sdot4(o0, wl_, yl[4 * dw + 0], false); \
                    yh[4 * dw + 1] = __builtin_amdgcn_sdot4(o1, wh_, yh[4 * dw + 1], false); yl[4 * dw + 1] = __builtin_amdgcn_sdot4(o1, wl_, yl[4 * dw + 1], false); \
                    yh[4 * dw + 2] = __builtin_amdgcn_sdot4(o2, wh_, yh[4 * dw + 2], false); yl[4 * dw + 2] = __builtin_amdgcn_sdot4(o2, wl_, yl[4 * dw + 2], false); \
                    yh[4 * dw + 3] = __builtin_amdgcn_sdot4(o3, wh_, yh[4 * dw + 3], false); yl[4 * dw + 3] = __builtin_amdgcn_sdot4(o3, wl_, yl[4 * dw + 3], false); } } \
            float y[16]; \
            _Pragma("unroll") for (int j = 0; j < 16; ++j) y[j] = (float)(yh[j] * 128 + yl[j]) * wsc[tk_]; \
            _Pragma("unroll") for (int j = 0; j < 16; ++j) { y[j] += dpp_f<0x128, 0xf>(y[j]); y[j] += __shfl_xor(y[j], 16); y[j] += __shfl_xor(y[j], 32); } \
            if (wr_) { if (p == 0) P9_OUT(X, c_, tk_, 0); else if (p == 1) P9_OUT(X, c_, tk_, 8); } \
            asm volatile("" ::: "memory"); } while (0)
        P9_VLOAD(rA, xA, 0, 0);
        for (int cc = 0; cc < 32 * P9_DUPV; ++cc) { const int c = cc & 31, cn = (cc + 1) & 31; const bool wr_ = (cc >= 32 * (P9_DUPV - 1)) || (wsc[0] == 12345.678f);
            P9_VLOAD(rB, xB, c, 1); P9_VPROC(rA, xA, c, 0);
            P9_VLOAD(rA, xA, c, 2); P9_VPROC(rB, xB, c, 1);
            P9_VLOAD(rB, xB, c, 3); P9_VPROC(rA, xA, c, 2);
            if (cc + 1 < 32 * P9_DUPV) P9_VLOAD(rA, xA, cn, 0);
            P9_VPROC(rB, xB, c, 3);
        }
#undef P9_VLOAD
#undef P9_VPROC
#undef P9_OUT
        LDS_WAIT();
    }
}

__device__ __forceinline__ void transpose_item_i8w(const float* W, int ld, int K, unsigned char* WQ, const float* skinv, LAS float* scr, int kb, int n0, int lane) {
    const int k0 = 128 * kb;
    float tv[64];
#pragma unroll
    for (int i = 0; i < 64; ++i) tv[i] = W[(size_t)(k0 + 2 * i + (lane >> 5)) * ld + n0 + (lane & 31)];
#pragma unroll
    for (int i = 0; i < 64; ++i) scr[(2 * i + (lane >> 5)) * 33 + (lane & 31)] = tv[i];
    const int c = lane & 7, nl = lane >> 3;
    float si[16];
#pragma unroll
    for (int q = 0; q < 4; ++q) { const f32x4 t = *(const f32x4*)(skinv + k0 + 16 * c + 4 * q); si[4 * q] = t.x; si[4 * q + 1] = t.y; si[4 * q + 2] = t.z; si[4 * q + 3] = t.w; }
    LDS_WAIT();
#pragma unroll
    for (int jj = 0; jj < 4; ++jj) { const int n = nl + 8 * jj; const LAS float* sp = scr + (16 * c) * 33 + n; v4u o;
#pragma unroll
        for (int q = 0; q < 4; ++q) { const int q0 = __float2int_rn(sp[(4 * q) * 33] * si[4 * q]), q1 = __float2int_rn(sp[(4 * q + 1) * 33] * si[4 * q + 1]), q2 = __float2int_rn(sp[(4 * q + 2) * 33] * si[4 * q + 2]), q3 = __float2int_rn(sp[(4 * q + 3) * 33] * si[4 * q + 3]);
            o[q] = ((unsigned)q0 & 255u) | (((unsigned)q1 & 255u) << 8) | (((unsigned)q2 & 255u) << 16) | (((unsigned)q3 & 255u) << 24); }
        *(v4u*)(WQ + (size_t)(n0 + n) * K + k0 + 16 * c) = o; }
    LDS_WAIT();
}
__device__ __forceinline__ void transpose_item_i8n(const float* W, int ld, int K, unsigned char* WQ, const unsigned* colmax_bits, LAS float* scr, int kb, int n0, int lane) {
    const int k0 = 64 * kb;
    float tv[32];
#pragma unroll
    for (int i = 0; i < 32; ++i) tv[i] = W[(size_t)(k0 + 2 * i + (lane >> 5)) * ld + n0 + (lane & 31)];
#pragma unroll
    for (int i = 0; i < 32; ++i) scr[(2 * i + (lane >> 5)) * 33 + (lane & 31)] = tv[i];
    const int c = lane & 3, nl = lane >> 2;
    LDS_WAIT();
#pragma unroll
    for (int jj = 0; jj < 2; ++jj) { const int n = nl + 16 * jj; const LAS float* sp = scr + (16 * c) * 33 + n; v4u o;
        const float mxv = __uint_as_float(colmax_bits[n0 + n]); const float si = mxv > 0.f ? 127.f / mxv : 1.f;
#pragma unroll
        for (int q = 0; q < 4; ++q) { const int q0 = __float2int_rn(sp[(4 * q) * 33] * si), q1 = __float2int_rn(sp[(4 * q + 1) * 33] * si), q2 = __float2int_rn(sp[(4 * q + 2) * 33] * si), q3 = __float2int_rn(sp[(4 * q + 3) * 33] * si);
            o[q] = ((unsigned)q0 & 255u) | (((unsigned)q1 & 255u) << 8) | (((unsigned)q2 & 255u) << 16) | (((unsigned)q3 & 255u) << 24); }
        *(v4u*)(WQ + (size_t)(n0 + n) * K + k0 + 16 * c) = o; }
    LDS_WAIT();
}
__device__ __forceinline__ void transpose_item_q8(const unsigned char* Wq, int ld, int K, unsigned char* WQ, LAS unsigned char* scr, int kb, int nb, int lane) {
    const int k0 = 128 * kb, n0 = 128 * nb;
    v4u tv[16];
#pragma unroll
    for (int i = 0; i < 16; ++i) tv[i] = *(const v4u*)(Wq + (size_t)(k0 + 8 * i + (lane >> 3)) * ld + n0 + 16 * (lane & 7));
#pragma unroll
    for (int i = 0; i < 16; ++i) { LAS unsigned* d = (LAS unsigned*)(scr + (8 * i + (lane >> 3)) * 132 + 16 * (lane & 7)); d[0] = tv[i].x; d[1] = tv[i].y; d[2] = tv[i].z; d[3] = tv[i].w; }
    LDS_WAIT();
    const int kc = lane & 7, nl = lane >> 3;
#pragma unroll
    for (int jj = 0; jj < 16; ++jj) { const int n = nl + 8 * jj; const LAS unsigned char* sp = scr + (16 * kc) * 132 + n; v4u o;
#pragma unroll
        for (int q = 0; q < 4; ++q) o[q] = (unsigned)sp[(4 * q) * 132] | ((unsigned)sp[(4 * q + 1) * 132] << 8) | ((unsigned)sp[(4 * q + 2) * 132] << 16) | ((unsigned)sp[(4 * q + 3) * 132] << 24);
        *(v4u*)(WQ + (size_t)(n0 + n) * K + k0 + 16 * kc) = o; }
    LDS_WAIT();
}
__device__ __forceinline__ void p1_transpose_win(const Args& a, LAS unsigned char* lds, int lane, int wave, int G) {
    const int gw = blockIdx.x * NWAVES + wave, NGW = G * NWAVES;
    LAS unsigned char* scr = lds + wave * 16896;
    for (int it = gw; it < 3072 + 1024 + 4096; it += NGW) {
        if (it < 3072) transpose_item_q8(a.ws + WS_WINKN, NQKV, DM, a.ws + WS_WINQ, scr, it / 96, it % 96, lane);
        else if (it < 4096) { const int r = it - 3072; transpose_item_q8(a.ws + WS_WOKN, DM, DM, a.ws + WS_WOQ, scr, r / 32, r % 32, lane); }
        else { const int r = it - 4096; transpose_item_i8n(a.in[13], PQ, DM, a.ws + WS_WPQQ, (const unsigned*)(a.ws + WS_PQMAX), (LAS float*)scr, r / 64, 32 * (r % 64), lane); }
    }
    __syncthreads();
}

#ifndef MK_ONE_LAUNCH
#define MK_ONE_LAUNCH 1
#endif
__global__ void __launch_bounds__(NTHR, 2) hymba_fwd(Args a) {
    extern __shared__ __attribute__((aligned(16))) unsigned char lds_raw[];
    LAS unsigned char* lds = (LAS unsigned char*)lds_raw;
    const int tid = threadIdx.x, lane = tid & 63, wave = __builtin_amdgcn_readfirstlane(tid >> 6), G = gridDim.x;
    volatile LAS unsigned* MISC = (volatile LAS unsigned*)(lds + MISC_OFF);
    if (tid < 64) MISC[tid] = 0u;
    __syncthreads();
    const int lo = a.ph_lo, hi = a.ph_hi;
    XcdBarrier bar; bar.bar = (unsigned*)(a.ws + WS_CTL) + CW_BAR; bar.x = 0; bar.st = nullptr;
    if (hi - lo > 1) bar = xcd_barrier_post((unsigned*)(a.ws + WS_CTL) + CW_BAR, MISC + 8);
#define IN(k) (lo <= (k) && (k) < hi)
#define SEAM(k) do { if (IN(k) && IN((k) + 1)) xcd_barrier(bar); } while (0)
    float* mod = (float*)(a.ws + WS_MOD);
    bf16* H = (bf16*)(a.ws + WS_H);

#ifndef DUP_MASK
#define DUP_MASK 0
#endif
#define RUN(k, ...) do { if (IN(k)) { __VA_ARGS__; if ((DUP_MASK >> (k)) & 1) { xcd_barrier(bar); __VA_ARGS__; } SEAM(k); } } while (0)
    RUN(0, ph0_prologue(a, lds, tid, lane, wave, G));
#ifndef P1_DUPT
#define P1_DUPT 0
#endif
#ifndef P1_DUPN
#define P1_DUPN 0
#endif
    RUN(1, { p1_transpose_win(a, lds, lane, wave, G); if (P1_DUPT) p1_transpose_win(a, lds, lane, wave, G);
        if (P1_DUPN) ph_norm<true>(a.in[0], a.in[4], mod + 0 * DM, mod + 1 * DM, H, a.ws + WS_H1Q, (float*)(a.ws + WS_HSC1), (const float*)(a.ws + WS_SKF), (const float*)(a.ws + WS_FGIMG), a.in[6], (float*)(a.ws + WS_LOGF), lds, lane, wave, G);
        ph_norm<true>(a.in[0], a.in[4], mod + 0 * DM, mod + 1 * DM, H, a.ws + WS_H1Q, (float*)(a.ws + WS_HSC1), (const float*)(a.ws + WS_SKF), (const float*)(a.ws + WS_FGIMG), a.in[6], (float*)(a.ws + WS_LOGF), lds, lane, wave, G); });
    RUN(2, { fcum_items(a, lds, tid, lane, wave, G);
        { pg8::Gemm g{(const pg8::bf16_t*)(a.ws + WS_H1Q), (const pg8::bf16_t*)(a.ws + WS_WINQ), NTOK, NQKV, DM / 2}; pg8::StaticOrder S; S.init(NTOK, NQKV, G, (int)blockIdx.x);
          pg8::EpiInProj<true> E{(pg8::bf16_t*)(a.ws + WS_PROJ), NQKV, 0, (const float*)(a.ws + WS_HSC1), (const float*)(a.ws + WS_GT), (float*)(a.ws + WS_KMEAN), (LAS float*)(lds + 131072), EPS};
          pg8::gemm_phase<pg8::EpiInProj<true>, pg8::StaticOrder, true, true, true>(lds, g, S, E); } });
    RUN(3, ph4_attn_mfma(a, lds, tid, lane, wave, G));
    RUN(4, ph_requant_mix(a, lane, wave, G));
    RUN(5, { pg8::Gemm g{(const pg8::bf16_t*)(a.ws + WS_MIXQ), (const pg8::bf16_t*)(a.ws + WS_WOQ), NTOK, DM, DM / 2}; pg8::StaticOrder S; S.init(NTOK, DM, G, (int)blockIdx.x);
        pg8::EpiResGateBf<true> E{a.in[0], (pg8::bf16_t*)(a.ws + WS_H), DM, mod + 2 * DM, SEQ, NMOD, (const float*)(a.ws + WS_MSC)};
        pg8::gemm_phase<pg8::EpiResGateBf<true>, pg8::StaticOrder, true, true, true>(lds, g, S, E); });
    RUN(6, ph_norm<false, false, true>((const float*)(a.ws + WS_H), a.in[12], mod + 3 * DM, mod + 4 * DM, H, a.ws + WS_H2Q, (float*)(a.ws + WS_HSC), nullptr, nullptr, nullptr, nullptr, lds, lane, wave, G));
    RUN(7, { pg8::Gemm g{(const pg8::bf16_t*)(a.ws + WS_H2Q), (const pg8::bf16_t*)(a.ws + WS_WPQQ), NTOK, PQ, DM / 2}; pg8::StaticOrder S; S.init(NTOK, PQ, G, (int)blockIdx.x);
        pg8::EpiBf16RC E{(pg8::bf16_t*)(a.ws + WS_QP), PQ, (const float*)(a.ws + WS_HSC), (const unsigned*)(a.ws + WS_PQMAX)};
        pg8::gemm_phase<pg8::EpiBf16RC, pg8::StaticOrder, true, true, true>(lds, g, S, E); });
    RUN(8, ph8_select(a, lds, tid, lane, wave, G));
    RUN(9, ph9_gather(a, lds, lane, wave, G));
#undef RUN
#undef IN
#undef SEAM
}

extern "C" void kernel_launch(void* const* d_in, const int* in_sizes, int n_in, void* d_out, int out_size, void* d_ws, size_t ws_size, hipStream_t stream) {
    static int grid = 0;
    if (grid == 0) {
        if (n_in != 17 || out_size != NTOK * DM || ws_size < WS_END) { fprintf(stderr, "kernel_launch: unexpected shapes (n_in %d out %d ws %zu)\n", n_in, out_size, ws_size); grid = -1; return; }
        int dev = 0, cus = 0, per_cu = 0;
        if (hipGetDevice(&dev) != hipSuccess || hipDeviceGetAttribute(&cus, hipDeviceAttributeMultiprocessorCount, dev) != hipSuccess) { grid = -1; return; }
        if (hipFuncSetAttribute((const void*)hymba_fwd, hipFuncAttributeMaxDynamicSharedMemorySize, LDS_BYTES) != hipSuccess) { fprintf(stderr, "kernel_launch: hipFuncSetAttribute failed\n"); grid = -1; return; }
        if (hipOccupancyMaxActiveBlocksPerMultiprocessor(&per_cu, (const void*)hymba_fwd, NTHR, LDS_BYTES) != hipSuccess || per_cu < 1)
            fprintf(stderr, "kernel_launch: note: occupancy query reports %d workgroups per CU\n", per_cu);
        (void)hipGetLastError();
        grid = cus;
    }
    if (grid < 0) return;
    if (hipMemsetAsync((char*)d_ws + WS_CTL, 0, ZERO_BYTES, stream) != hipSuccess) { fprintf(stderr, "kernel_launch: memset failed\n"); return; }
    Args a{};
    for (int i = 0; i < 17; ++i) a.in[i] = (const float*)d_in[i];
    a.out = (float*)d_out; a.ws = (unsigned char*)d_ws;
#if MK_ONE_LAUNCH
    a.ph_lo = 0; a.ph_hi = NPH;
    hipLaunchKernelGGL(hymba_fwd, dim3(grid), dim3(NTHR), LDS_BYTES, stream, a);
#else
    for (int p = 0; p < NPH; ++p) { a.ph_lo = p; a.ph_hi = p + 1; hipLaunchKernelGGL(hymba_fwd, dim3(grid), dim3(NTHR), LDS_BYTES, stream, a); }
#endif
}
```

```cpp
#include <hip/hip_runtime.h>
#include <cstdio>
#include <cstdint>
namespace pg8 {
#define PG8_LAS __attribute__((address_space(3)))
typedef unsigned short bf16_t;
typedef short bf16x8 __attribute__((ext_vector_type(8)));
typedef float f32x4 __attribute__((ext_vector_type(4)));
typedef unsigned u32x4 __attribute__((ext_vector_type(4)));
constexpr int BM = 256, BK = 64, HALF = 128, HTB = HALF * BK * 2  , STAGE_BYTES = 8 * HTB, NXCD = 8, WGM = 8;

__host__ __device__ __forceinline__ int lds_byte(int r, int c) { const int st = (r >> 4) * 2 + (c >> 5), rr = r & 15, cc = c & 31, ob = rr * 64 + cc * 2; return st * 1024 + (ob ^ (((ob >> 9) & 1) << 5)); }
__host__ __device__ __forceinline__ void stage_rc(int b, int& R, int& C) { const int st = b / 1024, sb = b % 1024, swz = sb ^ (((sb >> 9) & 1) << 5); R = (st >> 1) * 16 + swz / 64; C = (st & 1) * 32 + (swz % 64) / 2; }
__host__ __device__ __forceinline__ int perm32(int rho) { const int n = rho >> 4, i = rho & 15; return 8 * (i >> 2) + 4 * n + (i & 3); }

struct Unit { int pm, pn; };
struct Gemm { const bf16_t* A; const bf16_t* Bt; int M, N, K; };

struct StaticOrder {
    int nM, nN, nwg, G, c;
    __host__ __device__ void init(int M, int N, int G_, int c_) { nM = M / BM; nN = N / BM; nwg = nM * nN; G = G_; c = c_; }
    __host__ __device__ bool next(int i, Unit& u) const {
        const long L = (long)i * G + c; if (L >= nwg) return false;
        int wgid = (int)L; { const int q = nwg / NXCD, r = nwg % NXCD, xcd = wgid % NXCD, off = wgid / NXCD; wgid = (xcd < r ? xcd * (q + 1) : r * (q + 1) + (xcd - r) * q) + off; }
        const int nig = WGM * nN, gid = wgid / nig, fm = gid * WGM, gsz = (nM - fm) < WGM ? (nM - fm) : WGM;
        u.pm = fm + ((wgid % nig) % gsz); u.pn = (wgid % nig) / gsz; return true;
    }
    __device__ __forceinline__ void a_ready(const Unit&) const {}
    __device__ __forceinline__ void done(const Unit&) const {}
};

__device__ __forceinline__ unsigned cvt_pk_bf16(float lo, float hi) { unsigned r; asm volatile("v_cvt_pk_bf16_f32 %0, %1, %2" : "=v"(r) : "v"(lo), "v"(hi)); return r; }
typedef float f32x2 __attribute__((ext_vector_type(2)));
__device__ __forceinline__ f32x2 gelu_pk(f32x2 v) {
    const f32x2 av = __builtin_elementwise_abs(v), d = av * 0.2316418882f + 1.0f;
    f32x2 t; t.x = __builtin_amdgcn_rcpf(d.x); t.y = __builtin_amdgcn_rcpf(d.y);
    f32x2 q = t * 0.5307027145f + (-0.7265760135f); q = q * t + 0.7107068705f; q = q * t + (-0.142248368f); q = q * t + 0.127414796f; q = q * t;
    const f32x2 s = (v * v) * (-0.72134752044f);
    f32x2 e; e.x = __builtin_amdgcn_exp2f(s.x); e.y = __builtin_amdgcn_exp2f(s.y);
    const f32x2 m = v * (q * e), r = v - m;
    f32x2 o; o.x = v.x < 0.f ? m.x : r.x; o.y = v.y < 0.f ? m.y : r.y; return o;
}

template <int ACT  > struct EpiBf16 {
    static constexpr bool PERM = true, AFTER_DRAIN = false; static_assert(ACT == 0 || ACT == 1, "EpiBf16: ACT is 0 (none) or 1 (gelu_pk)");
    bf16_t* O; int ldc; const float* bias; int split_cols; size_t split_stride; float scale0;
    __device__ __forceinline__ void operator()(const f32x4 (&acc)[2][2][4][2], const Unit& u, int wr, int wc, int fr, int fq) const {
        const int row0 = u.pm * BM + wr * 64 + fr; int colt = u.pn * BM; bf16_t* base = O;
        float sc = 1.f; if (split_cols) { const int t = colt / split_cols; base += (size_t)t * split_stride; colt -= t * split_cols; if (t == 0) sc = scale0; }
        const int col0 = colt + wc * 32 + 8 * fq, bcol0 = u.pn * BM + wc * 32 + 8 * fq;
        f32x4 bv[2][2];
#pragma unroll
        for (int bj = 0; bj < 2; ++bj)
#pragma unroll
            for (int n = 0; n < 2; ++n) bv[bj][n] = bias ? *(const f32x4*)(bias + bcol0 + bj * HALF + 4 * n) : (f32x4){0.f, 0.f, 0.f, 0.f};
#pragma unroll
        for (int ai = 0; ai < 2; ++ai)
#pragma unroll
            for (int m = 0; m < 4; ++m) { bf16_t* rowp = base + (size_t)(row0 + ai * HALF + m * 16) * ldc + col0;
#pragma unroll
                for (int bj = 0; bj < 2; ++bj) { f32x4 v0 = acc[ai][bj][m][0] + bv[bj][0], v1 = acc[ai][bj][m][1] + bv[bj][1];
                    if (ACT == 1) { f32x2 a = gelu_pk((f32x2){v0[0], v0[1]}), b = gelu_pk((f32x2){v0[2], v0[3]}), c = gelu_pk((f32x2){v1[0], v1[1]}), d = gelu_pk((f32x2){v1[2], v1[3]});
                        v0 = (f32x4){a.x, a.y, b.x, b.y}; v1 = (f32x4){c.x, c.y, d.x, d.y}; }
                    v0 = v0 * sc; v1 = v1 * sc; u32x4 w; w.x = cvt_pk_bf16(v0[0], v0[1]); w.y = cvt_pk_bf16(v0[2], v0[3]); w.z = cvt_pk_bf16(v1[0], v1[1]); w.w = cvt_pk_bf16(v1[2], v1[3]);
                    *(u32x4*)(rowp + bj * HALF) = w; } }
    }
};
typedef int i32x4 __attribute__((ext_vector_type(4)));
template <bool I8> struct AccSel { typedef f32x4 type; };
template <> struct AccSel<true> { typedef i32x4 type; };
template <bool I8> struct EpiInProj {
    static constexpr bool PERM = true, AFTER_DRAIN = false;
    typedef typename AccSel<I8>::type acc_t;
    bf16_t* O; int ldc; int col_base; const float* rowscale;
    const float* gtab;
    float* kmean; PG8_LAS float* xs; float eps;
    static __device__ __forceinline__ f32x4 tof(const f32x4& a) { return a; }
    static __device__ __forceinline__ f32x4 tof(const i32x4& a) { return __builtin_convertvector(a, f32x4); }
    __device__ __forceinline__ void pre(const Unit& u, int wr, int fr, float (&rs)[8]) const { const int row0 = u.pm * BM + wr * 64 + fr;
#pragma unroll
        for (int ai = 0; ai < 2; ++ai)
#pragma unroll
            for (int m = 0; m < 4; ++m) rs[ai * 4 + m] = I8 ? rowscale[row0 + ai * HALF + m * 16] : 1.f; }
    __device__ __forceinline__ void operator()(const acc_t (&acc)[2][2][4][2], const Unit& u, int wr, int wc, int fr, int fq, const float (&rsp)[8]) const {
        asm volatile("" : "+v"(fr), "+v"(fq));
        const int colt = col_base + u.pn * BM, kind = colt >> 11;
        const int row0 = u.pm * BM + wr * 64 + fr;
        bf16_t* obase = O + (size_t)row0 * ldc + colt + wc * 32 + 8 * fq;
        if (kind == 2 || kind == 5) {
#pragma unroll
            for (int ai = 0; ai < 2; ++ai)
#pragma unroll
                for (int m = 0; m < 4; ++m) { const float rs = rsp[ai * 4 + m]; bf16_t* rowp = obase + (size_t)(ai * HALF + m * 16) * ldc;
#pragma unroll
                    for (int bj = 0; bj < 2; ++bj) { const f32x4 v0 = tof(acc[ai][bj][m][0]) * rs, v1 = tof(acc[ai][bj][m][1]) * rs;
                        u32x4 w; w.x = cvt_pk_bf16(v0[0], v0[1]); w.y = cvt_pk_bf16(v0[2], v0[3]); w.z = cvt_pk_bf16(v1[0], v1[1]); w.w = cvt_pk_bf16(v1[2], v1[3]);
                        *(u32x4*)(rowp + bj * HALF) = w; } }
            return;
        }
#pragma unroll
        for (int ai = 0; ai < 2; ++ai)
#pragma unroll
            for (int m = 0; m < 4; ++m)
#pragma unroll
                for (int bj = 0; bj < 2; ++bj) { const f32x4 a0 = tof(acc[ai][bj][m][0]), a1 = tof(acc[ai][bj][m][1]);
                    float s = (a0[0] * a0[0] + a0[1] * a0[1]) + (a0[2] * a0[2] + a0[3] * a0[3]) + (a1[0] * a1[0] + a1[1] * a1[1]) + (a1[2] * a1[2] + a1[3] * a1[3]);
                    s += __shfl_xor(s, 16); s += __shfl_xor(s, 32);
                    if (fq == 0) xs[(((wr * 2 + bj) * 128) + ai * 64 + m * 16 + fr) * 4 + wc] = s;
                    asm volatile("" ::: "memory"); }
        asm volatile("s_waitcnt lgkmcnt(0)" ::: "memory"); __builtin_amdgcn_s_barrier(); asm volatile("" ::: "memory");
        if (kind == 1) pass2<true>(acc, rsp, u, colt, kind, row0, obase, wr, wc, fr, fq); else pass2<false>(acc, rsp, u, colt, kind, row0, obase, wr, wc, fr, fq);
    }
    template <bool KM> __device__ __forceinline__ void pass2(const acc_t (&acc)[2][2][4][2], const float (&rsp)[8], const Unit& u, int colt, int kind, int row0, bf16_t* obase, int wr, int wc, int fr, int fq) const {
        const float* gain = gtab + kind * 128;
        const f32x4 gv0 = *(const f32x4*)(gain + wc * 32 + 8 * fq), gv1 = *(const f32x4*)(gain + wc * 32 + 8 * fq + 4);
        f32x4 cs[2][2];
#pragma unroll
        for (int bj = 0; bj < 2; ++bj) { cs[bj][0] = (f32x4){0.f, 0.f, 0.f, 0.f}; cs[bj][1] = cs[bj][0]; }
#pragma unroll
        for (int ai = 0; ai < 2; ++ai)
#pragma unroll
            for (int m = 0; m < 4; ++m) { const float rs = rsp[ai * 4 + m]; bf16_t* rowp = obase + (size_t)(ai * HALF + m * 16) * ldc;
#pragma unroll
                for (int bj = 0; bj < 2; ++bj) {
                    const f32x4 p4 = *(const PG8_LAS f32x4*)(xs + (((wr * 2 + bj) * 128) + ai * 64 + m * 16 + fr) * 4);
                    const float tot = ((p4[0] + p4[1]) + (p4[2] + p4[3])) * (rs * rs);
                    const float mult = rs / sqrtf(tot * (1.0f / 128.0f) + eps);
                    acc_t r0 = acc[ai][bj][m][0], r1 = acc[ai][bj][m][1]; asm volatile("" : "+v"(r0), "+v"(r1));
                    const f32x4 v0 = tof(r0) * mult * gv0, v1 = tof(r1) * mult * gv1;
                    if (KM) { cs[bj][0] += v0; cs[bj][1] += v1; }
                    u32x4 w; w.x = cvt_pk_bf16(v0[0], v0[1]); w.y = cvt_pk_bf16(v0[2], v0[3]); w.z = cvt_pk_bf16(v1[0], v1[1]); w.w = cvt_pk_bf16(v1[2], v1[3]);
                    *(u32x4*)(rowp + bj * HALF) = w; }
                if (KM) asm volatile("" : "+v"(cs[0][0]), "+v"(cs[0][1]), "+v"(cs[1][0]), "+v"(cs[1][1]));
                asm volatile("" ::: "memory"); }
        if (KM) {
            const int b = u.pm >> 3, blk = u.pm & 7, h0 = (colt - 2048) >> 7;
#pragma unroll
            for (int bj = 0; bj < 2; ++bj)
#pragma unroll
                for (int n = 0; n < 2; ++n)
#pragma unroll
                    for (int j = 0; j < 4; ++j) { float c = cs[bj][n][j];
                        c += __shfl_xor(c, 1); c += __shfl_xor(c, 2); c += __shfl_xor(c, 4); c += __shfl_xor(c, 8);
                        if (fr == 0) (void)__hip_atomic_fetch_add(kmean + (((size_t)b * 16 + h0 + bj) * 8 + blk) * 128 + wc * 32 + 8 * fq + 4 * n + j, c * (1.0f / 256.0f), __ATOMIC_RELAXED, __HIP_MEMORY_SCOPE_AGENT); }
        }
    }
};
template <bool I8> struct EpiResGate {
    static constexpr bool PERM = false, AFTER_DRAIN = false;
    typedef typename AccSel<I8>::type acc_t;
    const float* base; float* out; int ldc; const float* gate; int rows_per_batch; int gate_stride; const float* rowscale;
    static __device__ __forceinline__ f32x4 tof(const f32x4& a) { return a; }
    static __device__ __forceinline__ f32x4 tof(const i32x4& a) { return __builtin_convertvector(a, f32x4); }
    __device__ __forceinline__ void operator()(const acc_t (&acc)[2][2][4][2], const Unit& u, int wr, int wc, int fr, int fq) const {
        const int row0 = u.pm * BM + wr * 64 + fr, col0 = u.pn * BM + wc * 32 + 4 * fq;
        const int b = (u.pm * BM) / rows_per_batch;
        f32x4 gv[2][2];
#pragma unroll
        for (int bj = 0; bj < 2; ++bj)
#pragma unroll
            for (int n = 0; n < 2; ++n) gv[bj][n] = *(const f32x4*)(gate + (size_t)b * gate_stride + col0 + bj * HALF + n * 16);
#pragma unroll
        for (int ai = 0; ai < 2; ++ai)
#pragma unroll
            for (int m = 0; m < 4; ++m) { const size_t off = (size_t)(row0 + ai * HALF + m * 16) * ldc + col0; const float rs = I8 ? rowscale[row0 + ai * HALF + m * 16] : 1.f;
#pragma unroll
                for (int bj = 0; bj < 2; ++bj)
#pragma unroll
                    for (int n = 0; n < 2; ++n) { const f32x4 xb = *(const f32x4*)(base + off + bj * HALF + n * 16);
                        *(f32x4*)(out + off + bj * HALF + n * 16) = xb + gv[bj][n] * (tof(acc[ai][bj][m][n]) * rs); } }
    }
};

template <bool I8> struct EpiResGateBf {
    static constexpr bool PERM = true, AFTER_DRAIN = false;
    typedef typename AccSel<I8>::type acc_t;
    const float* base; bf16_t* O; int ldc; const float* gate; int rows_per_batch; int gate_stride; const float* rowscale;
    static __device__ __forceinline__ f32x4 tof(const f32x4& a) { return a; }
    static __device__ __forceinline__ f32x4 tof(const i32x4& a) { return __builtin_convertvector(a, f32x4); }
    __device__ __forceinline__ void pre(const Unit& u, int wr, int fr, float (&rs)[8]) const { const int row0 = u.pm * BM + wr * 64 + fr;
#pragma unroll
        for (int ai = 0; ai < 2; ++ai)
#pragma unroll
            for (int m = 0; m < 4; ++m) rs[ai * 4 + m] = I8 ? rowscale[row0 + ai * HALF + m * 16] : 1.f; }
    __device__ __forceinline__ void operator()(const acc_t (&acc)[2][2][4][2], const Unit& u, int wr, int wc, int fr, int fq, const float (&rsp)[8]) const {
        const int row0 = u.pm * BM + wr * 64 + fr, col0 = u.pn * BM + wc * 32 + 8 * fq;
        const int b = (u.pm * BM) / rows_per_batch;
        f32x4 gv[2][2];
#pragma unroll
        for (int bj = 0; bj < 2; ++bj)
#pragma unroll
            for (int n = 0; n < 2; ++n) gv[bj][n] = *(const f32x4*)(gate + (size_t)b * gate_stride + col0 + bj * HALF + 4 * n);
#pragma unroll
        for (int ai = 0; ai < 2; ++ai)
#pragma unroll
            for (int m = 0; m < 4; ++m) { const size_t off = (size_t)(row0 + ai * HALF + m * 16) * ldc + col0; const float rs = rsp[ai * 4 + m];
                f32x4 xv[2][2];
#pragma unroll
                for (int bj = 0; bj < 2; ++bj) { xv[bj][0] = *(const f32x4*)(base + off + bj * HALF); xv[bj][1] = *(const f32x4*)(base + off + bj * HALF + 4); }
#pragma unroll
                for (int bj = 0; bj < 2; ++bj) { const f32x4 v0 = xv[bj][0] + gv[bj][0] * (tof(acc[ai][bj][m][0]) * rs), v1 = xv[bj][1] + gv[bj][1] * (tof(acc[ai][bj][m][1]) * rs);
                    u32x4 w; w.x = cvt_pk_bf16(v0[0], v0[1]); w.y = cvt_pk_bf16(v0[2], v0[3]); w.z = cvt_pk_bf16(v1[0], v1[1]); w.w = cvt_pk_bf16(v1[2], v1[3]);
                    *(u32x4*)(O + off + bj * HALF) = w; } }
    }
};

struct EpiBf16RC {
    static constexpr bool PERM = true, AFTER_DRAIN = false;
    bf16_t* O; int ldc; const float* rowscale; const unsigned* colmax_bits;
    __device__ __forceinline__ void pre(const Unit& u, int wr, int fr, float (&rs)[8]) const { const int row0 = u.pm * BM + wr * 64 + fr;
#pragma unroll
        for (int ai = 0; ai < 2; ++ai)
#pragma unroll
            for (int m = 0; m < 4; ++m) rs[ai * 4 + m] = rowscale[row0 + ai * HALF + m * 16]; }
    __device__ __forceinline__ void operator()(const i32x4 (&acc)[2][2][4][2], const Unit& u, int wr, int wc, int fr, int fq, const float (&rsp)[8]) const {
        asm volatile("" : "+v"(fr), "+v"(fq));
        const int row0 = u.pm * BM + wr * 64 + fr, col0 = u.pn * BM + wc * 32 + 8 * fq;
        f32x4 cv[2][2];
#pragma unroll
        for (int bj = 0; bj < 2; ++bj)
#pragma unroll
            for (int n = 0; n < 2; ++n) { const u32x4 b = *(const u32x4*)(colmax_bits + col0 + bj * HALF + 4 * n);
                cv[bj][n] = (f32x4){__uint_as_float(b.x), __uint_as_float(b.y), __uint_as_float(b.z), __uint_as_float(b.w)} * (1.0f / 127.0f); }
#pragma unroll
        for (int ai = 0; ai < 2; ++ai)
#pragma unroll
            for (int m = 0; m < 4; ++m) { const float rs = rsp[ai * 4 + m]; bf16_t* rowp = O + (size_t)(row0 + ai * HALF + m * 16) * ldc + col0;
#pragma unroll
                for (int bj = 0; bj < 2; ++bj) { const f32x4 v0 = __builtin_convertvector(acc[ai][bj][m][0], f32x4) * rs * cv[bj][0], v1 = __builtin_convertvector(acc[ai][bj][m][1], f32x4) * rs * cv[bj][1];
                    u32x4 w; w.x = cvt_pk_bf16(v0[0], v0[1]); w.y = cvt_pk_bf16(v0[2], v0[3]); w.z = cvt_pk_bf16(v1[0], v1[1]); w.w = cvt_pk_bf16(v1[2], v1[3]);
                    *(u32x4*)(rowp + bj * HALF) = w; } }
    }
};
__device__ __forceinline__ f32x4 mma_step(f32x4 c, bf16x8 b, bf16x8 a) { return __builtin_amdgcn_mfma_f32_16x16x32_bf16(b, a, c, 0, 0, 0); }
__device__ __forceinline__ i32x4 mma_step(i32x4 c, bf16x8 b, bf16x8 a) { return __builtin_amdgcn_mfma_i32_16x16x64_i8(__builtin_bit_cast(i32x4, b), __builtin_bit_cast(i32x4, a), c, 0, 0, 0); }
template <class Epi, class Sched, bool ALIGN_EPI = false, bool SP2 = false, bool I8 = false>
__device__ __forceinline__ void gemm_phase(PG8_LAS unsigned char* lds, const Gemm g, const Sched& S, const Epi& E) {
    const int tid = threadIdx.x, wid = __builtin_amdgcn_readfirstlane(tid >> 6), lane = tid & 63, wr = wid >> 2, wc = wid & 3, fr = lane & 15, fq = lane >> 4;
    const int K = g.K, nt = K / BK;
    unsigned voffA[2], voffB[2];
#pragma unroll
    for (int i = 0; i < 2; ++i) { int R, C; stage_rc(tid * 16 + i * 8192, R, C); const int Rb = Epi::PERM ? ((R & ~31) + perm32(R & 31)) : R;
        voffA[i] = (unsigned)(R * K + C) * 2u; voffB[i] = (unsigned)(Rb * K + C) * 2u; }
    const size_t kstep = (size_t)(BK * 2);
    const size_t hstep = (size_t)HALF * K * 2;
    const size_t tstep = 2 * hstep;
    const unsigned ldsw = (unsigned)wid * 1024u;
    const int aoff = lds_byte(wr * 64 + fr, fq * 8), boff = lds_byte(wc * 32 + fr, fq * 8);
#define PG8_SA(b, h) (((b) * 2 + (h)) * HTB)
#define PG8_SB(b, h) ((4 + (b) * 2 + (h)) * HTB)
#define PG8_STAGE(bufoff, gbase, voff) do { _Pragma("unroll") for (int _i = 0; _i < 2; ++_i) \
        __builtin_amdgcn_global_load_lds((const unsigned*)((const char*)(gbase) + (voff)[_i]), (PG8_LAS unsigned*)(lds + (bufoff) + ldsw + _i * 8192), 16, 0, 0); } while (0)
#define PG8_LDA(dst, b, h) do { _Pragma("unroll") for (int m = 0; m < 4; ++m) _Pragma("unroll") for (int k = 0; k < 2; ++k) dst[m][k] = *(const PG8_LAS bf16x8*)(lds + PG8_SA(b, h) + aoff + m * 2048 + k * 1024); } while (0)
#define PG8_LDB(dst, b, h) do { _Pragma("unroll") for (int n = 0; n < 2; ++n) _Pragma("unroll") for (int k = 0; k < 2; ++k) dst[n][k] = *(const PG8_LAS bf16x8*)(lds + PG8_SB(b, h) + boff + n * 2048 + k * 1024); } while (0)
#define PG8_MMA(ai, bj, At, Bt) do { __builtin_amdgcn_s_setprio(1); _Pragma("unroll") for (int m = 0; m < 4; ++m) _Pragma("unroll") for (int n = 0; n < 2; ++n) _Pragma("unroll") for (int k = 0; k < 2; ++k) \
        acc[ai][bj][m][n] = mma_step(acc[ai][bj][m][n], Bt[n][k], At[m][k]); __builtin_amdgcn_s_setprio(0); } while (0)
#define PG8_WAIT_V(n) asm volatile("s_waitcnt vmcnt(" #n ")" ::: "memory")
#define PG8_WAIT_L(n) asm volatile("s_waitcnt lgkmcnt(" #n ")" ::: "memory")
#define PG8_BAR __builtin_amdgcn_s_barrier()
#define PG8_SCHED __builtin_amdgcn_sched_barrier(0)
    Unit cur, nxt; int ui = 0;
    if (!S.next(0, cur)) return;
    typedef typename AccSel<I8>::type acc_t;
    acc_t acc[2][2][4][2];
#pragma unroll
    for (int a = 0; a < 2; ++a)
#pragma unroll
        for (int b = 0; b < 2; ++b)
#pragma unroll
            for (int m = 0; m < 4; ++m)
#pragma unroll
                for (int n = 0; n < 2; ++n) acc[a][b][m][n] = (acc_t){0, 0, 0, 0};
    bf16x8 At[4][2], B0[2][2], B1[2][2];
    const char* cA = (const char*)g.A + (size_t)cur.pm * tstep; const char* cB = (const char*)g.Bt + (size_t)cur.pn * tstep;
    S.a_ready(cur);
    if constexpr (SP2) {
        PG8_STAGE(PG8_SB(0, 0), cB, voffB); PG8_STAGE(PG8_SB(0, 1), cB + hstep, voffB); PG8_STAGE(PG8_SA(0, 0), cA, voffA); PG8_STAGE(PG8_SA(0, 1), cA + hstep, voffA);
        if (wr == 1) PG8_BAR;
        PG8_WAIT_V(2); PG8_BAR;
        PG8_STAGE(PG8_SB(1, 0), cB + kstep, voffB); PG8_STAGE(PG8_SA(1, 0), cA + kstep, voffA); PG8_STAGE(PG8_SB(1, 1), cB + hstep + kstep, voffB);
        PG8_WAIT_V(6); PG8_BAR;
    } else {
        PG8_STAGE(PG8_SB(0, 0), cB, voffB); PG8_STAGE(PG8_SA(0, 0), cA, voffA); PG8_STAGE(PG8_SB(0, 1), cB + hstep, voffB); PG8_STAGE(PG8_SA(0, 1), cA + hstep, voffA);
        if (wr == 1) PG8_BAR;
        PG8_WAIT_V(4); PG8_BAR;
        PG8_STAGE(PG8_SB(1, 0), cB + kstep, voffB); PG8_STAGE(PG8_SA(1, 0), cA + kstep, voffA); PG8_STAGE(PG8_SB(1, 1), cB + hstep + kstep, voffB);
        PG8_WAIT_V(6); PG8_BAR;
    }
    for (;;) {
        const bool has_next = S.next(ui + 1, nxt);
        const char* nA = has_next ? (const char*)g.A + (size_t)nxt.pm * tstep : cA; const char* nB = has_next ? (const char*)g.Bt + (size_t)nxt.pn * tstep : cB;
        float rsp[8]; E.pre(cur, wr, fr, rsp);
        for (int t = 0; t < nt; t += 2) {
            const bool last = (t == nt - 2);
            const char* a1 = cA + (size_t)(t + 1) * kstep;
            const char* a2 = last ? nA : cA + (size_t)(t + 2) * kstep; const char* b2 = last ? nB : cB + (size_t)(t + 2) * kstep;
            const char* a3 = a2 + kstep; const char* b3 = b2 + kstep;
            if (last && has_next) S.a_ready(nxt);
            if constexpr (SP2) {
            PG8_LDB(B0, 0, 0); PG8_LDB(B1, 0, 1); PG8_SCHED; PG8_LDA(At, 0, 0); PG8_STAGE(PG8_SA(1, 1), a1 + hstep, voffA);
            PG8_WAIT_V(8); PG8_WAIT_L(0); PG8_BAR; PG8_MMA(0, 0, At, B0); PG8_MMA(0, 1, At, B1); PG8_BAR; PG8_SCHED;
            PG8_LDA(At, 0, 1); PG8_STAGE(PG8_SB(0, 0), b2, voffB); PG8_STAGE(PG8_SB(0, 1), b2 + hstep, voffB); PG8_STAGE(PG8_SA(0, 0), a2, voffA);
            PG8_WAIT_V(8); PG8_WAIT_L(0); PG8_BAR; PG8_MMA(1, 0, At, B0); PG8_MMA(1, 1, At, B1); PG8_BAR; PG8_SCHED;
            PG8_LDB(B0, 1, 0); PG8_LDB(B1, 1, 1); PG8_SCHED; PG8_LDA(At, 1, 0); PG8_STAGE(PG8_SA(0, 1), a2 + hstep, voffA);
            PG8_WAIT_V(8); PG8_WAIT_L(0); PG8_BAR; PG8_MMA(0, 0, At, B0); PG8_MMA(0, 1, At, B1); PG8_BAR; PG8_SCHED;
            PG8_LDA(At, 1, 1); PG8_STAGE(PG8_SB(1, 0), b3, voffB); PG8_STAGE(PG8_SB(1, 1), b3 + hstep, voffB); PG8_STAGE(PG8_SA(1, 0), a3, voffA);
            PG8_WAIT_V(8); PG8_WAIT_L(0); PG8_BAR; PG8_MMA(1, 0, At, B0); PG8_MMA(1, 1, At, B1); PG8_BAR; PG8_SCHED;
            } else {
            PG8_LDB(B0, 0, 0); PG8_SCHED; PG8_LDA(At, 0, 0); PG8_STAGE(PG8_SA(1, 1), a1 + hstep, voffA);
            PG8_WAIT_L(8); PG8_BAR; PG8_WAIT_L(0); PG8_MMA(0, 0, At, B0); PG8_BAR; PG8_SCHED;
            PG8_LDB(B1, 0, 1); PG8_STAGE(PG8_SB(0, 0), b2, voffB);
            PG8_BAR; PG8_WAIT_L(0); PG8_MMA(0, 1, At, B1); PG8_BAR;
            PG8_LDA(At, 0, 1); PG8_STAGE(PG8_SA(0, 0), a2, voffA);
            PG8_BAR; PG8_WAIT_L(0); PG8_MMA(1, 0, At, B0); PG8_BAR; PG8_SCHED;
            PG8_STAGE(PG8_SB(0, 1), b2 + hstep, voffB);
            PG8_WAIT_V(6); PG8_BAR; PG8_MMA(1, 1, At, B1); PG8_BAR;
            PG8_LDB(B0, 1, 0); PG8_SCHED; PG8_LDA(At, 1, 0); PG8_STAGE(PG8_SA(0, 1), a2 + hstep, voffA);
            PG8_WAIT_L(8); PG8_BAR; PG8_WAIT_L(0); PG8_MMA(0, 0, At, B0); PG8_BAR; PG8_SCHED;
            PG8_LDB(B1, 1, 1); PG8_STAGE(PG8_SB(1, 0), b3, voffB);
            PG8_BAR; PG8_WAIT_L(0); PG8_MMA(0, 1, At, B1); PG8_BAR;
            PG8_LDA(At, 1, 1); PG8_STAGE(PG8_SA(1, 0), a3, voffA);
            PG8_BAR; PG8_WAIT_L(0); PG8_MMA(1, 0, At, B0); PG8_BAR; PG8_SCHED;
            PG8_STAGE(PG8_SB(1, 1), b3 + hstep, voffB);
            PG8_WAIT_V(6); PG8_BAR; PG8_MMA(1, 1, At, B1); PG8_BAR;
            }
        }
        if constexpr (ALIGN_EPI) { if (wr == 0) PG8_BAR; }
        if constexpr (!Epi::AFTER_DRAIN) { E(acc, cur, wr, wc, fr, fq, rsp); S.done(cur); }
        if (!has_next) break;
#pragma unroll
        for (int a = 0; a < 2; ++a)
#pragma unroll
            for (int b = 0; b < 2; ++b)
#pragma unroll
                for (int m = 0; m < 4; ++m)
#pragma unroll
                    for (int n = 0; n < 2; ++n) acc[a][b][m][n] = (acc_t){0, 0, 0, 0};
        cur = nxt; cA = nA; cB = nB; ++ui;
        if constexpr (ALIGN_EPI) { if (wr == 1) PG8_BAR; }
    }
    PG8_WAIT_V(0);
    if constexpr (!ALIGN_EPI) { if (wr == 0) PG8_BAR; }
    PG8_BAR;
    if constexpr (Epi::AFTER_DRAIN) { E.fused(acc, cur, wr, wc, fr, fq, lds, wid, lane); S.done(cur); }
#undef PG8_SA
#undef PG8_SB
#undef PG8_STAGE
#undef PG8_LDA
#undef PG8_LDB
#undef PG8_MMA
#undef PG8_WAIT_V
#undef PG8_WAIT_L
#undef PG8_BAR
#undef PG8_SCHED
}
}
#define GAS __attribute__((address_space(1)))
#define LAS __attribute__((address_space(3)))
#define XB_TMO      128
#define XB_XCNT(j)  (256  + 64 * (j))
#define XB_XSUB(j)  (1280 + 64 * (j))
#define XB_XGEN(j)  (2304 + 64 * (j))
#define XB_TOP      3328
#define XB_TOPGEN   3392
#define XCD_BAR_WORDS 3456
#define XB_SPIN_CAP (1u << 18)

__device__ __forceinline__ unsigned xb_ld(unsigned* p)              { return __hip_atomic_load(p, __ATOMIC_RELAXED, __HIP_MEMORY_SCOPE_AGENT); }
__device__ __forceinline__ unsigned xb_add(unsigned* p, unsigned v) { return __hip_atomic_fetch_add(p, v, __ATOMIC_RELAXED, __HIP_MEMORY_SCOPE_AGENT); }
__device__ __forceinline__ unsigned xb_xcc_id() { return (unsigned)__builtin_amdgcn_s_getreg((3 << 11) | 20) & 0xFu; }
#define XB_SPIN(cond, bar) do { unsigned _sp = 0; while (cond) { __builtin_amdgcn_s_sleep(1); \
    if ((++_sp & 255u) == 0u) { if (xb_ld(&(bar)[XB_TMO])) break; if (_sp > XB_SPIN_CAP) { atomicAdd(&(bar)[XB_TMO], 1u); break; } } } } while (0)

struct XcdBarrier {
    unsigned* bar; unsigned x;
    volatile LAS unsigned* st;
};

__device__ __forceinline__ XcdBarrier xcd_barrier_post(unsigned* bar, volatile LAS unsigned* st) {
    XcdBarrier b; b.bar = bar; b.x = xb_xcc_id(); b.st = st;
    if (threadIdx.x == 0) (void)xb_add(&bar[XB_XCNT(b.x)], 1u);
    return b;
}
__device__ __forceinline__ void xcd_barrier_complete(unsigned* bar, unsigned x, unsigned& nloc, unsigned& nx) {
    const unsigned G = gridDim.x * gridDim.y * gridDim.z;
    unsigned sum, cnt, mine, sp = 0u;
    for (;;) {
        sum = 0u; cnt = 0u; mine = 0u;
#pragma unroll
        for (unsigned j = 0; j < 16; ++j) { const unsigned c = xb_ld(&bar[XB_XCNT(j)]); sum += c; cnt += (c > 0u) ? 1u : 0u; mine = (j == x) ? c : mine; }
        if (sum == G) break;
        __builtin_amdgcn_s_sleep(1);
        if ((++sp & 255u) == 0u) { if (xb_ld(&bar[XB_TMO])) break; if (sp > XB_SPIN_CAP) { atomicAdd(&bar[XB_TMO], 1u); break; } }
    }
    nloc = mine > 0u ? mine : 1u; nx = cnt > 0u ? cnt : 1u;
}

__device__ __forceinline__ void xcd_barrier(const XcdBarrier& b) {
    asm volatile("s_waitcnt vmcnt(0)" ::: "memory");
    __syncthreads();
    if (threadIdx.x == 0) {
        unsigned* bar = b.bar;
        __builtin_amdgcn_s_waitcnt(0);
        unsigned nloc = b.st[0], nx = b.st[1];
        if (nloc == 0u) { xcd_barrier_complete(bar, b.x, nloc, nx); b.st[0] = nloc; b.st[1] = nx; }
        const unsigned old = xb_add(&bar[XB_XSUB(b.x)], 1u);
        const unsigned gen = old / nloc;
        if (old + 1u == (gen + 1u) * nloc) {
            __builtin_amdgcn_fence(__ATOMIC_RELEASE, "agent");
            asm volatile("s_waitcnt vmcnt(0)" ::: "memory");
            const unsigned og = xb_add(&bar[XB_TOP], 1u);
            const unsigned tg = og / nx;
            if (og + 1u == (tg + 1u) * nx) xb_add(&bar[XB_TOPGEN], 1u);
            else XB_SPIN(xb_ld(&bar[XB_TOPGEN]) == tg, bar);
            __builtin_amdgcn_fence(__ATOMIC_ACQUIRE, "agent");
            xb_add(&bar[XB_XGEN(b.x)], 1u);
            asm volatile("s_waitcnt vmcnt(0)" ::: "memory");
        } else {
            XB_SPIN(xb_ld(&bar[XB_XGEN(b.x)]) == gen, bar);
            __builtin_amdgcn_fence(__ATOMIC_ACQUIRE, "agent");
            asm volatile("s_waitcnt vmcnt(0)" ::: "memory");
        }
    }
    __syncthreads();
}
constexpr int NB = 4, SEQ = 2048, DM = 4096, NTOK = NB * SEQ, DIN = 12304, NQKV = 12288, HD = 128;
constexpr int NMOD = 6 * DM, PQ = 2048;
constexpr float EPS = 1e-6f;
constexpr int NWAVES = 8, NTHR = 512;
constexpr int NPH = 10;

constexpr size_t MiB = 1u << 20;
constexpr size_t WS_CTL = 0;
constexpr size_t WS_MOD = 1 * MiB;
constexpr size_t WS_KMEAN = 1 * MiB + 512 * 1024;
constexpr size_t ZERO_BYTES = 2 * MiB;
constexpr size_t WS_LOGF = 2 * MiB;
constexpr size_t WS_FCUM = 3 * MiB;
constexpr size_t WS_SKB = 4 * MiB;
constexpr size_t WS_EIDX = 8 * MiB;
constexpr size_t WS_GATE = 12 * MiB;
constexpr size_t WS_WINT = 16 * MiB;
constexpr size_t WS_WOT = 112 * MiB;
constexpr size_t WS_WPQT = 144 * MiB;
constexpr size_t WS_H = 160 * MiB;
constexpr size_t WS_PROJ = 224 * MiB;
constexpr size_t WS_MIX = 416 * MiB;
constexpr size_t WS_QP = 480 * MiB;
constexpr size_t WS_UB = 512 * MiB;
constexpr size_t WS_VB = 640 * MiB;
constexpr size_t WS_H2Q = 768 * MiB;
constexpr size_t WS_WINQ = 920 * MiB;
constexpr size_t WS_H1Q = 840 * MiB;
constexpr size_t WS_WOQ = 872 * MiB;
constexpr size_t WS_MIXQ = 888 * MiB;
constexpr size_t WS_END = 968 * MiB;
constexpr size_t WS_WINKN = 32 * MiB, WS_WOKN = 96 * MiB;
constexpr size_t WS_PQMAX = 1 * MiB + 786432;
constexpr size_t WS_WPQQ = 16 * MiB;
constexpr size_t WS_FGIMG = 6 * MiB;
constexpr size_t WS_SKOINV = 5 * MiB + 393216, WS_SKOF = 5 * MiB + 393216 + 16384, WS_MSC = 5 * MiB + 458752;
constexpr size_t WS_SKINV = 5 * MiB + 196608, WS_SKF = 5 * MiB + 196608 + 16384, WS_HSC1 = 5 * MiB + 262144, WS_GT = 5 * MiB + 327680;
constexpr size_t WS_USC = 5 * MiB, WS_VSC = 5 * MiB + 65536, WS_HSC = 5 * MiB + 131072;
constexpr int CW_BAR = 4096;

constexpr int LDS_BYTES = 163840, MISC_OFF = LDS_BYTES - 256;

#define GAS __attribute__((address_space(1)))
#define LAS __attribute__((address_space(3)))
typedef unsigned short bf16;
typedef unsigned v4u __attribute__((ext_vector_type(4)));
typedef unsigned v2u __attribute__((ext_vector_type(2)));
typedef float f32x4 __attribute__((ext_vector_type(4)));
typedef short bf16x8 __attribute__((ext_vector_type(8)));
#define LDS_WAIT() asm volatile("s_waitcnt lgkmcnt(0)" ::: "memory")

__device__ __forceinline__ unsigned f2bf(float f) { unsigned u = __builtin_bit_cast(unsigned, f); return (u + 0x7fffu + ((u >> 16) & 1u)) >> 16; }
__device__ __forceinline__ unsigned pk2(float lo, float hi) { return f2bf(lo) | (f2bf(hi) << 16); }
__device__ __forceinline__ float bf_lo(unsigned u) { return __uint_as_float(u << 16); }
__device__ __forceinline__ float bf_hi(unsigned u) { return __uint_as_float(u & 0xffff0000u); }
__device__ __forceinline__ float wave_sum(float v) {
#pragma unroll
    for (int o = 1; o < 64; o <<= 1) v += __shfl_xor(v, o);
    return v;
}
__device__ __forceinline__ int tokey(unsigned u) { const int s = (int)u; return s ^ ((s >> 31) & 0x7fffffff); }
__device__ __forceinline__ unsigned unkey(int k) { return (unsigned)(k ^ ((k >> 31) & 0x7fffffff)); }

template <int CTRL, int ROW_MASK> __device__ __forceinline__ float dpp_f(float v) { return __builtin_bit_cast(float, __builtin_amdgcn_update_dpp(0, __builtin_bit_cast(int, v), CTRL, ROW_MASK, 0xf, false)); }
#define WAVE_SUM63(v) do { v += dpp_f<0xB1, 0xf>(v); v += dpp_f<0x4E, 0xf>(v); v += dpp_f<0x141, 0xf>(v); v += dpp_f<0x140, 0xf>(v); v += dpp_f<0x142, 0xa>(v); v += dpp_f<0x143, 0xc>(v); } while (0)

typedef __bf16 bf16x2_t __attribute__((ext_vector_type(2)));
__device__ __forceinline__ float dot2bf(unsigned a, unsigned b, float acc) { return __builtin_amdgcn_fdot2_f32_bf16(__builtin_bit_cast(bf16x2_t, a), __builtin_bit_cast(bf16x2_t, b), acc, false); }
struct Args { const float* in[17]; float* out; unsigned char* ws; int ph_lo, ph_hi; };

__device__ __forceinline__ void transpose_item(const float* W, int ld, int K, bf16* WT, LAS float* scr, int kb, int nb, int lane) {
    const int k0 = 64 * kb, n0 = 32 * nb;
    float tv[32];
#pragma unroll
    for (int i = 0; i < 32; ++i) tv[i] = W[(size_t)(k0 + 2 * i + (lane >> 5)) * ld + n0 + (lane & 31)];
#pragma unroll
    for (int i = 0; i < 32; ++i) scr[(2 * i + (lane >> 5)) * 33 + (lane & 31)] = tv[i];
    LDS_WAIT();
    const int c = lane & 7;
#pragma unroll
    for (int j = 0; j < 4; ++j) { const int n = (lane >> 3) + 8 * j; const LAS float* s = scr + (8 * c) * 33 + n;
        v4u o; o.x = pk2(s[0 * 33], s[1 * 33]); o.y = pk2(s[2 * 33], s[3 * 33]); o.z = pk2(s[4 * 33], s[5 * 33]); o.w = pk2(s[6 * 33], s[7 * 33]);
        *(v4u*)(WT + (size_t)(n0 + n) * K + k0 + 8 * c) = o; }
    LDS_WAIT();
}

__device__ __forceinline__ void transpose_item_i8(const float* W, int ld, int K, unsigned char* WQ, const float* skinv, LAS float* scr, int kb, int n_src0, int n_dst0, int lane) {
    const int k0 = 64 * kb;
    float tv[32];
#pragma unroll
    for (int i = 0; i < 32; ++i) tv[i] = W[(size_t)(k0 + 2 * i + (lane >> 5)) * ld + n_src0 + (lane & 31)];
#pragma unroll
    for (int i = 0; i < 32; ++i) scr[(2 * i + (lane >> 5)) * 33 + (lane & 31)] = tv[i];
    const int c = lane & 3, nl = lane >> 2;
    float si[16];
#pragma unroll
    for (int q = 0; q < 4; ++q) { const f32x4 t = *(const f32x4*)(skinv + k0 + 16 * c + 4 * q); si[4 * q] = t.x; si[4 * q + 1] = t.y; si[4 * q + 2] = t.z; si[4 * q + 3] = t.w; }
    LDS_WAIT();
#pragma unroll
    for (int jj = 0; jj < 2; ++jj) { const int n = nl + 16 * jj; const LAS float* sp = scr + (16 * c) * 33 + n; v4u o;
#pragma unroll
        for (int q = 0; q < 4; ++q) { const int q0 = __float2int_rn(sp[(4 * q) * 33] * si[4 * q]), q1 = __float2int_rn(sp[(4 * q + 1) * 33] * si[4 * q + 1]), q2 = __float2int_rn(sp[(4 * q + 2) * 33] * si[4 * q + 2]), q3 = __float2int_rn(sp[(4 * q + 3) * 33] * si[4 * q + 3]);
            o[q] = ((unsigned)q0 & 255u) | (((unsigned)q1 & 255u) << 8) | (((unsigned)q2 & 255u) << 16) | (((unsigned)q3 & 255u) << 24); }
        *(v4u*)(WQ + (size_t)(n_dst0 + n) * K + k0 + 16 * c) = o; }
    LDS_WAIT();
}

__device__ __forceinline__ void ph0_prologue(const Args& a, LAS unsigned char* lds, int tid, int lane, int wave, int G) {
    const float* c = a.in[1]; const float* w_ada = a.in[2]; const float* b_ada = a.in[3];
    float* mod = (float*)(a.ws + WS_MOD);
    LAS float* cs = (LAS float*)lds;
    LAS f32x4* red = (LAS f32x4*)(lds + 65536);
    for (int i = tid; i < 4 * DM; i += NTHR) { const float cv = c[i]; cs[i] = cv / (1.f + __expf(-cv)); }
    __syncthreads();
#ifndef P0_DUPG
#define P0_DUPG 1
#endif
#ifndef P0_DUPC
#define P0_DUPC 1
#endif
    const int kg = tid / 24, cq = tid % 24;
    for (int rep_ = 0; rep_ < P0_DUPG; ++rep_)
    for (int it = blockIdx.x; it < 256; it += G) {
        if (tid < 504) {
            const float* wp = w_ada + (size_t)kg * NMOD + it * 96 + cq * 4;
            f32x4 acc0 = {0.f, 0.f, 0.f, 0.f}, acc1 = acc0, acc2 = acc0, acc3 = acc0;
            const int nrow = (DM - kg + 20) / 21;
#pragma unroll 8
            for (int i = 0; i < nrow; ++i) {
                const f32x4 w = *(const f32x4*)(wp + (size_t)(21 * i) * NMOD);
                const int k = kg + 21 * i;
                acc0 += cs[k] * w; acc1 += cs[DM + k] * w; acc2 += cs[2 * DM + k] * w; acc3 += cs[3 * DM + k] * w;
            }
            red[(kg * 4 + 0) * 24 + cq] = acc0; red[(kg * 4 + 1) * 24 + cq] = acc1; red[(kg * 4 + 2) * 24 + cq] = acc2; red[(kg * 4 + 3) * 24 + cq] = acc3;
        }
        __syncthreads();
        if (tid < 96) { const int b = tid / 24, q = tid % 24;
            f32x4 s = *(const f32x4*)(b_ada + it * 96 + q * 4);
            for (int g = 0; g < 21; ++g) s += red[(g * 4 + b) * 24 + q];
            *(f32x4*)(mod + (size_t)b * NMOD + it * 96 + q * 4) = s; }
        __syncthreads();
    }
    const int gw = blockIdx.x * NWAVES + wave, NGW = G * NWAVES;
    LAS float* scr = (LAS float*)(lds + 81920 + wave * 8448);
    { unsigned* pqmax = (unsigned*)(a.ws + WS_PQMAX);
      for (int it = gw; it < 2048; it += NGW) { const int cg = it & 63, slab = it >> 6; const float* wp = a.in[13] + (size_t)(slab * 128 + (lane >> 5)) * PQ + 32 * cg + (lane & 31); float mx = 0.f;
#pragma unroll 16
          for (int i = 0; i < 64; ++i) mx = fmaxf(mx, fabsf(wp[(size_t)(2 * i) * PQ]));
          mx = fmaxf(mx, __shfl_xor(mx, 32));
          if (lane < 32) atomicMax(pqmax + 32 * cg + lane, __float_as_uint(mx)); } }
    if (blockIdx.x == 0 && tid < 128) { float* gt = (float*)(a.ws + WS_GT); gt[tid] = a.in[7][tid]; gt[128 + tid] = a.in[8][tid]; gt[256 + tid] = 0.f; gt[384 + tid] = a.in[9][tid]; gt[512 + tid] = a.in[10][tid]; gt[640 + tid] = 0.f; }
    { const f32x4* sk = (const f32x4*)a.in[14]; v4u* skb = (v4u*)(a.ws + WS_SKB);
      for (int i = blockIdx.x * NTHR + tid; i < 32768; i += G * NTHR) { const f32x4 p = sk[2 * i], q = sk[2 * i + 1];
          v4u o; o.x = pk2(p.x, p.y); o.y = pk2(p.z, p.w); o.z = pk2(q.x, q.y); o.w = pk2(q.z, q.w); skb[i] = o; } }
    for (int ci = blockIdx.x * NTHR + tid; ci < 8192; ci += G * NTHR) { const int g = ci >> 3, q = ci & 7, kp = q >> 2, cq = q & 3, k = 4 * g + 2 * kp; const float* w_in = a.in[5];
        const f32x4 w0 = *(const f32x4*)(w_in + (size_t)k * DIN + NQKV + 4 * cq), w1 = *(const f32x4*)(w_in + (size_t)(k + 1) * DIN + NQKV + 4 * cq);
        v4u o; o.x = pk2(w0.x, w1.x); o.y = pk2(w0.y, w1.y); o.z = pk2(w0.z, w1.z); o.w = pk2(w0.w, w1.w);
        *(v4u*)(a.ws + WS_FGIMG + 128 * g + 16 * (q ^ ((g >> 1) & 7))) = o; }
    { const float* Uf = a.in[15]; const float* Vf = a.in[16]; float* usc = (float*)(a.ws + WS_USC); float* vsc = (float*)(a.ws + WS_VSC);
      for (int rep_ = 0; rep_ < P0_DUPC; ++rep_) {
      f32x4 vn[16];
      { const int r0 = gw; const f32x4* s0 = (const f32x4*)((r0 >= 16384 ? Vf : Uf) + (size_t)(r0 & 16383) * DM) + lane;
#pragma unroll
        for (int j = 0; j < 16; ++j) vn[j] = r0 < 16384 ? s0[64 * j] : (f32x4){0.f, 0.f, 0.f, 0.f}; }
      for (int r = gw; r < 16384; r += NGW) {
          const bool isv = false; const int e = r;
          f32x4 v[16]; float mx = 0.f;
#pragma unroll
          for (int j = 0; j < 16; ++j) { v[j] = vn[j]; mx = fmaxf(mx, fmaxf(fmaxf(fabsf(v[j].x), fabsf(v[j].y)), fmaxf(fabsf(v[j].z), fabsf(v[j].w)))); }
          { const int rn = r + NGW; if (rn < 16384) { const f32x4* sn = (const f32x4*)((rn >= 16384 ? Vf : Uf) + (size_t)(rn & 16383) * DM) + lane;
#pragma unroll
              for (int j = 0; j < 16; ++j) vn[j] = sn[64 * j]; } }
#pragma unroll
          for (int o = 1; o < 64; o <<= 1) mx = fmaxf(mx, __shfl_xor(mx, o));
          const float sc = mx > 0.f ? mx * (1.f / 127.f) : 1.f, inv = 1.f / sc;
          if (lane == 0) (isv ? vsc : usc)[e] = sc;
          unsigned char* dst = a.ws + (isv ? WS_VB : WS_UB) + (size_t)e * 128 + ((4 * lane) & 127);
          const int bias = isv ? 128 : 0;
#pragma unroll
          for (int j = 0; j < 16; ++j) {
              const int q0 = __float2int_rn(v[j].x * inv) + bias, q1 = __float2int_rn(v[j].y * inv) + bias, q2 = __float2int_rn(v[j].z * inv) + bias, q3 = __float2int_rn(v[j].w * inv) + bias;
              const unsigned pk = ((unsigned)q0 & 255u) | (((unsigned)q1 & 255u) << 8) | (((unsigned)q2 & 255u) << 16) | (((unsigned)q3 & 255u) << 24);
              *(unsigned*)(dst + (size_t)(2 * j + (lane >> 5)) * (16384 * 128)) = pk; }
      } } }
    { float* skinv = (float*)(a.ws + WS_SKOINV); float* skf = (float*)(a.ws + WS_SKOF); unsigned char* dq = a.ws + WS_WOKN;
      for (int k = gw; k < DM; k += NGW) {
          const f32x4* src = (const f32x4*)(a.in[11] + (size_t)k * DM) + lane; f32x4 v[16]; float mx = 0.f;
#pragma unroll
          for (int j = 0; j < 16; ++j) { v[j] = src[64 * j]; mx = fmaxf(mx, fmaxf(fmaxf(fabsf(v[j].x), fabsf(v[j].y)), fmaxf(fabsf(v[j].z), fabsf(v[j].w)))); }
#pragma unroll
          for (int o = 1; o < 64; o <<= 1) mx = fmaxf(mx, __shfl_xor(mx, o));
          const float sc = mx > 0.f ? mx * (1.f / 127.f) : 1.f, inv = 1.f / sc;
          if (lane == 0) { skf[k] = sc; skinv[k] = inv; }
          unsigned* dp = (unsigned*)(dq + (size_t)k * DM) + lane;
#pragma unroll
          for (int j = 0; j < 16; ++j) { const int q0 = __float2int_rn(v[j].x * inv), q1 = __float2int_rn(v[j].y * inv), q2 = __float2int_rn(v[j].z * inv), q3 = __float2int_rn(v[j].w * inv);
              dp[64 * j] = ((unsigned)q0 & 255u) | (((unsigned)q1 & 255u) << 8) | (((unsigned)q2 & 255u) << 16) | (((unsigned)q3 & 255u) << 24); } } }
    { float* skinv = (float*)(a.ws + WS_SKINV); float* skf = (float*)(a.ws + WS_SKF); unsigned char* dq = a.ws + WS_WINKN;
      for (int k = gw; k < DM; k += NGW) {
          const f32x4* src = (const f32x4*)(a.in[5] + (size_t)k * DIN) + lane; f32x4 v[48]; float mx = 0.f;
#pragma unroll
          for (int j = 0; j < 48; ++j) v[j] = src[64 * j];
#pragma unroll
          for (int j = 0; j < 48; ++j) mx = fmaxf(mx, fmaxf(fmaxf(fabsf(v[j].x), fabsf(v[j].y)), fmaxf(fabsf(v[j].z), fabsf(v[j].w))));
#pragma unroll
          for (int o = 1; o < 64; o <<= 1) mx = fmaxf(mx, __shfl_xor(mx, o));
          const float sc = mx > 0.f ? mx * (1.f / 127.f) : 1.f, inv = 1.f / sc;
          if (lane == 0) { skf[k] = sc; skinv[k] = inv; }
          unsigned* dp = (unsigned*)(dq + (size_t)k * NQKV) + lane;
#pragma unroll
          for (int j = 0; j < 48; ++j) { const int q0 = __float2int_rn(v[j].x * inv), q1 = __float2int_rn(v[j].y * inv), q2 = __float2int_rn(v[j].z * inv), q3 = __float2int_rn(v[j].w * inv);
              dp[64 * j] = ((unsigned)q0 & 255u) | (((unsigned)q1 & 255u) << 8) | (((unsigned)q2 & 255u) << 16) | (((unsigned)q3 & 255u) << 24); } } }
}

template <bool FG, bool WH = true, bool XB = false>
__device__ __forceinline__ void ph_norm(const float* xin, const float* gnorm, const float* sh, const float* sc, bf16* H, unsigned char* H2Q, float* HSC, const float* qcol,
                                        const float* w_in, const float* b_f, float* logf, LAS unsigned char* lds, int lane, int wave, int G) {
    const int gw = blockIdx.x * NWAVES + wave, NGW = G * NWAVES;
    const LAS unsigned char* wfl = lds;
    if (FG) {
        const v4u* img = (const v4u*)w_in; v4u t[16];
#pragma unroll
        for (int i = 0; i < 16; ++i) t[i] = img[threadIdx.x + NTHR * i];
#pragma unroll
        for (int i = 0; i < 16; ++i) *(LAS v4u*)(lds + 16 * (threadIdx.x + NTHR * i)) = t[i];
        __syncthreads();
    }
    for (int m = gw; m < NTOK; m += NGW) {
        int ln = lane; asm volatile("" : "+v"(ln));
        const int b = m / SEQ;
        const f32x4* xr = (const f32x4*)(xin + (size_t)m * DM) + ln;
        f32x4 v[16]; float ss = 0.f;
#pragma unroll
        for (int j = 0; j < 16; ++j) { if (XB) { const v2u t = ((const v2u*)((const bf16*)xin + (size_t)m * DM) + ln)[64 * j]; v[j] = (f32x4){bf_lo(t.x), bf_hi(t.x), bf_lo(t.y), bf_hi(t.y)}; } else v[j] = xr[64 * j];
            ss += (v[j].x * v[j].x + v[j].y * v[j].y) + (v[j].z * v[j].z + v[j].w * v[j].w); }
        ss = wave_sum(ss);
        const float rstd = 1.0f / sqrtf(ss * (1.f / DM) + EPS);
        v2u* ho = (v2u*)(H + (size_t)m * DM) + ln; float hmx = 0.f;
#pragma unroll
        for (int j = 0; j < 16; ++j) { const int col = 4 * ln + 256 * j;
            const f32x4 g = *(const f32x4*)(gnorm + col), s1 = *(const f32x4*)(sc + (size_t)b * NMOD + col), s0 = *(const f32x4*)(sh + (size_t)b * NMOD + col);
            const f32x4 hv = v[j] * rstd * g * (1.f + s1) + s0;
            if (!FG && WH) { v2u o; o.x = pk2(hv.x, hv.y); o.y = pk2(hv.z, hv.w); ho[64 * j] = o; }
            v[j] = hv;
            const f32x4 hq = FG ? hv * *(const f32x4*)(qcol + col) : hv;
            hmx = fmaxf(hmx, fmaxf(fmaxf(fabsf(hq.x), fabsf(hq.y)), fmaxf(fabsf(hq.z), fabsf(hq.w))));
            if (j == 7) asm volatile("" ::: "memory"); }
        {
#pragma unroll
            for (int o = 1; o < 64; o <<= 1) hmx = fmaxf(hmx, __shfl_xor(hmx, o));
            const float qs = hmx > 0.f ? hmx * (1.f / 127.f) : 1.f, qi = 1.f / qs;
            if (ln == 0) HSC[m] = qs;
            int lq = ln;
            unsigned* qo = (unsigned*)(H2Q + (size_t)m * DM) + lq;
            asm volatile("" ::: "memory");
            f32x4 qc[16];
#pragma unroll
            for (int j = 0; j < 16; ++j) qc[j] = FG ? *(const f32x4*)(qcol + 4 * ln + 256 * j) : (f32x4){1.f, 1.f, 1.f, 1.f};
#pragma unroll
            for (int j = 0; j < 16; ++j) { const f32x4 hq = v[j] * qc[j] * qi;
                const int q0 = __float2int_rn(hq.x), q1 = __float2int_rn(hq.y), q2 = __float2int_rn(hq.z), q3 = __float2int_rn(hq.w);
                qo[64 * j] = ((unsigned)q0 & 255u) | (((unsigned)q1 & 255u) << 8) | (((unsigned)q2 & 255u) << 16) | (((unsigned)q3 & 255u) << 24); }
        }
        if (FG) {
            float fa[16];
#pragma unroll
            for (int c = 0; c < 16; ++c) fa[c] = 0.f;
#pragma unroll
            for (int j = 0; j < 16; ++j) { const int g = ln + 64 * j; const LAS unsigned char* gp = wfl + 128 * g; const int sw = (g >> 1) & 7;
#pragma unroll
                for (int kp = 0; kp < 2; ++kp) { const unsigned hpk = pg8::cvt_pk_bf16(v[j][2 * kp], v[j][2 * kp + 1]);
#pragma unroll
                    for (int cq = 0; cq < 4; ++cq) { const v4u w = *(const LAS v4u*)(gp + 16 * ((4 * kp + cq) ^ sw));
                        fa[4 * cq + 0] = dot2bf(w.x, hpk, fa[4 * cq + 0]); fa[4 * cq + 1] = dot2bf(w.y, hpk, fa[4 * cq + 1]); fa[4 * cq + 2] = dot2bf(w.z, hpk, fa[4 * cq + 2]); fa[4 * cq + 3] = dot2bf(w.w, hpk, fa[4 * cq + 3]); } }
                asm volatile("" ::: "memory"); }
            float z = 0.f;
#pragma unroll
            for (int c = 0; c < 16; ++c) { float t = fa[c]; WAVE_SUM63(t); const float tot = __builtin_bit_cast(float, __builtin_amdgcn_readlane(__builtin_bit_cast(int, t), 63)); z = (ln == c) ? tot : z; }
            { int ll = ln;
              if (ll < 16) { z += b_f[ll]; logf[((size_t)b * 16 + ll) * SEQ + (m % SEQ)] = fminf(z, 0.f) - log1pf(__expf(-fabsf(z))); } }
        }
    }
}

template <bool FG>
__device__ __forceinline__ void ph_norm2(const float* xin, const float* gnorm, const float* sh, const float* sc, bf16* H, unsigned char* H2Q, float* HSC, const float* qcol,
                                        const float* w_in, const float* b_f, float* logf, LAS unsigned char* lds, int lane, int wave, int G) {
    const int gw = blockIdx.x * NWAVES + wave, NGW = G * NWAVES;
    const LAS unsigned char* wfl = lds;
    if (FG) {
        for (int ci = threadIdx.x; ci < 8192; ci += NTHR) { const int g = ci >> 3, q = ci & 7, kp = q >> 2, cq = q & 3, k = 4 * g + 2 * kp;
            const f32x4 w0 = *(const f32x4*)(w_in + (size_t)k * DIN + NQKV + 4 * cq), w1 = *(const f32x4*)(w_in + (size_t)(k + 1) * DIN + NQKV + 4 * cq);
            v4u o; o.x = pk2(w0.x, w1.x); o.y = pk2(w0.y, w1.y); o.z = pk2(w0.z, w1.z); o.w = pk2(w0.w, w1.w);
            *(LAS v4u*)(lds + 128 * g + 16 * (q ^ ((g >> 1) & 7))) = o; }
        __syncthreads();
    }
    for (int mp = gw; mp < NTOK / 2; mp += NGW) {
        const int m0 = 2 * mp, b = m0 / SEQ;
        f32x4 v[2][16]; float rstd[2];
#pragma unroll
        for (int r = 0; r < 2; ++r) { const f32x4* xr = (const f32x4*)(xin + (size_t)(m0 + r) * DM) + lane; float ss = 0.f;
#pragma unroll
            for (int j = 0; j < 16; ++j) { v[r][j] = xr[64 * j]; ss += (v[r][j].x * v[r][j].x + v[r][j].y * v[r][j].y) + (v[r][j].z * v[r][j].z + v[r][j].w * v[r][j].w); }
            ss = wave_sum(ss); rstd[r] = 1.0f / sqrtf(ss * (1.f / DM) + EPS); }
        float hmx[2] = {0.f, 0.f};
#pragma unroll
        for (int j = 0; j < 16; ++j) { const int col = 4 * lane + 256 * j;
            const f32x4 g = *(const f32x4*)(gnorm + col), s1 = *(const f32x4*)(sc + (size_t)b * NMOD + col), s0 = *(const f32x4*)(sh + (size_t)b * NMOD + col);
            const f32x4 ga = g * (1.f + s1);
            f32x4 qc = {1.f, 1.f, 1.f, 1.f}; if (FG) qc = *(const f32x4*)(qcol + col);
#pragma unroll
            for (int r = 0; r < 2; ++r) { const f32x4 hv = v[r][j] * rstd[r] * ga + s0;
                v2u o; o.x = pk2(hv.x, hv.y); o.y = pk2(hv.z, hv.w); ((v2u*)(H + (size_t)(m0 + r) * DM) + lane)[64 * j] = o;
                v[r][j] = hv;
                const f32x4 hq = hv * qc;
                hmx[r] = fmaxf(hmx[r], fmaxf(fmaxf(fabsf(hq.x), fabsf(hq.y)), fmaxf(fabsf(hq.z), fabsf(hq.w)))); }
            if (j & 1) asm volatile("" ::: "memory"); }
        {
            float qi[2];
#pragma unroll
            for (int r = 0; r < 2; ++r) {
#pragma unroll
                for (int o = 1; o < 64; o <<= 1) hmx[r] = fmaxf(hmx[r], __shfl_xor(hmx[r], o));
                const float qs = hmx[r] > 0.f ? hmx[r] * (1.f / 127.f) : 1.f; qi[r] = 1.f / qs;
                if (lane == 0) HSC[m0 + r] = qs; }
#pragma unroll
            for (int j = 0; j < 16; ++j) { f32x4 qc = {1.f, 1.f, 1.f, 1.f}; if (FG) qc = *(const f32x4*)(qcol + 4 * lane + 256 * j);
#pragma unroll
                for (int r = 0; r < 2; ++r) { const f32x4 hq = v[r][j] * qc * qi[r];
                    const int q0 = __float2int_rn(hq.x), q1 = __float2int_rn(hq.y), q2 = __float2int_rn(hq.z), q3 = __float2int_rn(hq.w);
                    ((unsigned*)(H2Q + (size_t)(m0 + r) * DM) + lane)[64 * j] = ((unsigned)q0 & 255u) | (((unsigned)q1 & 255u) << 8) | (((unsigned)q2 & 255u) << 16) | (((unsigned)q3 & 255u) << 24); }
                if (j & 1) asm volatile("" ::: "memory"); }
        }
    }
}

__device__ __forceinline__ void fcum_items(const Args& a, LAS unsigned char* lds, int tid, int lane, int wave, int G) {
    const float* LOGF = (const float*)(a.ws + WS_LOGF); float* FCUM = (float*)(a.ws + WS_FCUM);
    LAS float* wt = (LAS float*)(lds + 16384);
    for (int bh = blockIdx.x; bh < 64; bh += G) {
        f32x4 v = ((const f32x4*)(LOGF + (size_t)bh * SEQ))[tid];
        v.y += v.x; v.z += v.y; v.w += v.z; const float tot = v.w;
        float sc = tot;
#pragma unroll
        for (int o = 1; o < 64; o <<= 1) { const float t = __shfl_up(sc, o); if (lane >= o) sc += t; }
        __syncthreads();
        if (lane == 63) wt[wave] = sc;
        __syncthreads();
        float base = 0.f; for (int w = 0; w < wave; ++w) base += wt[w];
        const float excl = base + sc - tot;
        v.x += excl; v.y += excl; v.z += excl; v.w += excl;
        ((f32x4*)(FCUM + (size_t)bh * SEQ))[tid] = v;
    }
    __syncthreads();
}

__device__ __forceinline__ void ph4_attn_naive(const Args& a, LAS unsigned char* lds, int tid, int lane, int wave, int G) {
    const bf16* PROJ = (const bf16*)(a.ws + WS_PROJ); const float* KMEAN = (const float*)(a.ws + WS_KMEAN); const float* FCUM = (const float*)(a.ws + WS_FCUM);
    bf16* MIX = (bf16*)(a.ws + WS_MIX);
    LAS bf16* Ks = (LAS bf16*)lds; LAS bf16* Vs = (LAS bf16*)(lds + 16384); LAS float* Fs = (LAS float*)(lds + 32768);
    const int qi = tid >> 3, dg = tid & 7;
    const float scale = 0.08838834764831845f;
    for (int it = blockIdx.x; it < 4096; it += G) {
        const int qt = 31 - (it >> 7), rest = it & 127; const bool moba = rest < 64; const int bh = rest & 63, b = bh >> 4, h = bh & 15;
        const int t = qt * 64 + qi, qblk = qt >> 2;
        const int qc = moba ? 0 : 6144, kc = moba ? 2048 : 8192, vc = moba ? 4096 : 10240;
        float q[16];
        { const v4u* qp = (const v4u*)(PROJ + (size_t)(b * SEQ + t) * NQKV + qc + h * 128 + dg * 16); const v4u w0 = qp[0], w1 = qp[1];
          q[0] = bf_lo(w0.x); q[1] = bf_hi(w0.x); q[2] = bf_lo(w0.y); q[3] = bf_hi(w0.y); q[4] = bf_lo(w0.z); q[5] = bf_hi(w0.z); q[6] = bf_lo(w0.w); q[7] = bf_hi(w0.w);
          q[8] = bf_lo(w1.x); q[9] = bf_hi(w1.x); q[10] = bf_lo(w1.y); q[11] = bf_hi(w1.y); q[12] = bf_lo(w1.z); q[13] = bf_hi(w1.z); q[14] = bf_lo(w1.w); q[15] = bf_hi(w1.w);
#pragma unroll
          for (int i = 0; i < 16; ++i) q[i] *= scale; }
        unsigned selmask = 0u;
        if (moba) {
            float gate[8];
#pragma unroll
            for (int n = 0; n < 8; ++n) { float d = 0.f;
                if (n < qblk) { const float* km = KMEAN + ((size_t)bh * 8 + n) * 128 + dg * 16;
#pragma unroll
                    for (int i = 0; i < 16; ++i) d += q[i] * km[i]; }
                d += __shfl_xor(d, 1); d += __shfl_xor(d, 2); d += __shfl_xor(d, 4);
                gate[n] = (n < qblk) ? d : -1e30f; }
            if (qblk <= 3) selmask = (1u << qblk) - 1u;
            else {
#pragma unroll
                for (int r = 0; r < 3; ++r) { float bv = -3e38f; int bi = 0;
#pragma unroll
                    for (int n = 0; n < 8; ++n) if (gate[n] > bv) { bv = gate[n]; bi = n; }
                    selmask |= 1u << bi;
#pragma unroll
                    for (int n = 0; n < 8; ++n) if (n == bi) gate[n] = -3e38f; }
            }
        }
        float mx = -1e30f, l = 0.f, o[16];
#pragma unroll
        for (int i = 0; i < 16; ++i) o[i] = 0.f;
        const float slope = exp2f(-0.5f * (float)(h + 1));
        const float Ft = moba ? 0.f : FCUM[(size_t)bh * SEQ + t];
        for (int kt = 0; kt <= qt; ++kt) {
            const int blk = kt >> 2;
            __syncthreads();
            for (int i = tid; i < 1024; i += NTHR) { const int key = i >> 4, ch = i & 15; const size_t g = (size_t)(b * SEQ + kt * 64 + key) * NQKV + h * 128 + ch * 8;
                ((LAS v4u*)Ks)[i] = *(const v4u*)(PROJ + g + kc); ((LAS v4u*)Vs)[i] = *(const v4u*)(PROJ + g + vc); }
            if (!moba && tid < 64) Fs[tid] = FCUM[(size_t)bh * SEQ + kt * 64 + tid];
            __syncthreads();
            const bool need = moba ? ((blk == qblk) || ((selmask >> blk) & 1u)) : true;
            if (__any(need)) {
                for (int j = 0; j < 64; ++j) {
                    const int s = kt * 64 + j;
                    const LAS v4u* kp = (const LAS v4u*)(Ks + j * 128 + dg * 16); const v4u k0 = kp[0], k1 = kp[1];
                    float d = q[0] * bf_lo(k0.x) + q[1] * bf_hi(k0.x) + q[2] * bf_lo(k0.y) + q[3] * bf_hi(k0.y) + q[4] * bf_lo(k0.z) + q[5] * bf_hi(k0.z) + q[6] * bf_lo(k0.w) + q[7] * bf_hi(k0.w)
                            + q[8] * bf_lo(k1.x) + q[9] * bf_hi(k1.x) + q[10] * bf_lo(k1.y) + q[11] * bf_hi(k1.y) + q[12] * bf_lo(k1.z) + q[13] * bf_hi(k1.z) + q[14] * bf_lo(k1.w) + q[15] * bf_hi(k1.w);
                    d += __shfl_xor(d, 1); d += __shfl_xor(d, 2); d += __shfl_xor(d, 4);
                    const bool valid = need && (s <= t);
                    const float logit = moba ? d - slope * (float)(t - s) : d + Ft - Fs[j];
                    if (valid) {
                        if (logit > mx) { const float al = __expf(mx - logit); l *= al;
#pragma unroll
                            for (int i = 0; i < 16; ++i) o[i] *= al;
                            mx = logit; }
                        const float p = __expf(logit - mx); l += p;
                        const LAS v4u* vp = (const LAS v4u*)(Vs + j * 128 + dg * 16); const v4u v0 = vp[0], v1 = vp[1];
                        o[0] += p * bf_lo(v0.x); o[1] += p * bf_hi(v0.x); o[2] += p * bf_lo(v0.y); o[3] += p * bf_hi(v0.y); o[4] += p * bf_lo(v0.z); o[5] += p * bf_hi(v0.z); o[6] += p * bf_lo(v0.w); o[7] += p * bf_hi(v0.w);
                        o[8] += p * bf_lo(v1.x); o[9] += p * bf_hi(v1.x); o[10] += p * bf_lo(v1.y); o[11] += p * bf_hi(v1.y); o[12] += p * bf_lo(v1.z); o[13] += p * bf_hi(v1.z); o[14] += p * bf_lo(v1.w); o[15] += p * bf_hi(v1.w);
                    }
                }
            }
        }
        const float inv = 1.f / l;
        v4u o0, o1; o0.x = pk2(o[0] * inv, o[1] * inv); o0.y = pk2(o[2] * inv, o[3] * inv); o0.z = pk2(o[4] * inv, o[5] * inv); o0.w = pk2(o[6] * inv, o[7] * inv);
        o1.x = pk2(o[8] * inv, o[9] * inv); o1.y = pk2(o[10] * inv, o[11] * inv); o1.z = pk2(o[12] * inv, o[13] * inv); o1.w = pk2(o[14] * inv, o[15] * inv);
        v4u* op = (v4u*)(MIX + (size_t)(b * SEQ + t) * DM + (moba ? 0 : 2048) + h * 128 + dg * 16); op[0] = o0; op[1] = o1;
    }
}

typedef float f32x16 __attribute__((ext_vector_type(16)));
typedef short s16x4 __attribute__((ext_vector_type(4)));
constexpr int AT_KSTR = 272, AT_VSTR = 320;
constexpr int AT_K0 = 0, AT_KB = 64 * AT_KSTR, AT_V0 = 2 * AT_KB, AT_VB = 64 * AT_VSTR, AT_B0 = AT_V0 + 2 * AT_VB, AT_BB = 256;
__device__ __forceinline__ s16x4 at_vtr(const LAS unsigned char* p) { return __builtin_bit_cast(s16x4, __builtin_amdgcn_ds_read_tr16_b64_v4i16((LAS s16x4*)p)); }
__device__ __forceinline__ unsigned at_cvtpk(float lo, float hi) { unsigned r; asm("v_cvt_pk_bf16_f32 %0, %1, %2" : "=v"(r) : "v"(lo), "v"(hi)); return r; }

__device__ __forceinline__ void ph4_attn_mfma(const Args& a, LAS unsigned char* lds, int tid, int lane, int wave, int G) {
    const bf16* PROJ = (const bf16*)(a.ws + WS_PROJ); const float* KMEAN = (const float*)(a.ws + WS_KMEAN); const float* FCUM = (const float*)(a.ws + WS_FCUM);
    bf16* MIX = (bf16*)(a.ws + WS_MIX);
    const int q32 = lane & 31, hi = lane >> 5;
    const float C1 = 0.08838834764831845f * 1.4426950408889634f, LOG2E = 1.4426950408889634f;
    const int vlane = (4 * hi + ((lane & 15) >> 2)) * AT_VSTR + (16 * ((lane >> 4) & 1) + 4 * (lane & 3)) * 2;
    const int klane = q32 * AT_KSTR + hi * 16;
    for (int pi = blockIdx.x; pi < 512; pi += G) {
      for (int half = 0; half < 2; ++half) {
        const int khb = pi >> 2, jq = pi & 3;
        const int qb = half == 0 ? 7 - jq : jq;
        const bool moba = khb < 64; const int bh = khb & 63, b = bh >> 4, h = bh & 15;
        const int qc = moba ? 0 : 6144, kc = moba ? 2048 : 8192, vc = moba ? 4096 : 10240;
        const int t0 = qb * 256, tw = t0 + 32 * wave;
        const bf16* pbase = PROJ + (size_t)(b * SEQ) * NQKV + h * 128;
        v4u qf[8];
        { const bf16* qp = pbase + (size_t)(tw + q32) * NQKV + qc + 8 * hi;
#pragma unroll
          for (int ks = 0; ks < 8; ++ks) qf[ks] = *(const v4u*)(qp + 16 * ks); }
        unsigned selmask = 0u;
        if (moba && qb > 0) {
            float gate[8];
#pragma unroll
            for (int n = 0; n < 8; ++n) { float d = 0.f;
                if (n < qb) { const float* km = KMEAN + ((size_t)bh * 8 + n) * 128 + 8 * hi;
#pragma unroll
                    for (int ks = 0; ks < 8; ++ks) { const f32x4 k0 = *(const f32x4*)(km + 16 * ks), k1 = *(const f32x4*)(km + 16 * ks + 4); const v4u w = qf[ks];
                        d += bf_lo(w.x) * k0.x + bf_hi(w.x) * k0.y + bf_lo(w.y) * k0.z + bf_hi(w.y) * k0.w + bf_lo(w.z) * k1.x + bf_hi(w.z) * k1.y + bf_lo(w.w) * k1.z + bf_hi(w.w) * k1.w; } }
                d += __shfl_xor(d, 32);
                gate[n] = (n < qb) ? d : -1e30f; }
            if (qb <= 3) selmask = (1u << qb) - 1u;
            else {
#pragma unroll
                for (int r = 0; r < 3; ++r) { float bv = -3e38f; int bi = 0;
#pragma unroll
                    for (int n = 0; n < 8; ++n) if (gate[n] > bv) { bv = gate[n]; bi = n; }
                    selmask |= 1u << bi;
#pragma unroll
                    for (int n = 0; n < 8; ++n) if (n == bi) gate[n] = -3e38f; }
            }
        }
        const float slope2 = exp2f(-0.5f * (float)(h + 1)) * LOG2E;
        const float Fref = moba ? 0.f : FCUM[(size_t)bh * SEQ + t0];
        float mrow = -1e30f, lrow = 0.f;
        f32x16 o[4];
#pragma unroll
        for (int db = 0; db < 4; ++db)
#pragma unroll
            for (int r = 0; r < 16; ++r) o[db][r] = 0.f;
        const int ntiles = 4 * (qb + 1);
        v4u sk0 = {0u, 0u, 0u, 0u}, sk1 = sk0, sv0 = sk0, sv1 = sk0, tk0 = sk0, tk1 = sk0, tv0 = sk0, tv1 = sk0; float sbias = 0.f, tbias = 0.f;
        const int skey0 = tid >> 4, sch = tid & 15;
#define AT_ISSUE(idx_, K0_, K1_, V0_, V1_, B_) do { const int bp_ = (idx_) >> 2, ti_ = (idx_) & 3; const int kb_ = bp_ == 0 ? qb : bp_ - 1; const int key0_ = kb_ * 256 + ti_ * 64; \
            const bf16* g0_ = pbase + (size_t)(key0_ + skey0) * NQKV + sch * 8; const bf16* g1_ = g0_ + (size_t)32 * NQKV; \
            K0_ = *(const v4u*)(g0_ + kc); K1_ = *(const v4u*)(g1_ + kc); V0_ = *(const v4u*)(g0_ + vc); V1_ = *(const v4u*)(g1_ + vc); \
            (void)B_; } while (0)
#define AT_WRITE(idx_, K0_, K1_, V0_, V1_, B_) do { const int bf_ = (idx_) & 1; \
            *(LAS v4u*)(lds + AT_K0 + bf_ * AT_KB + skey0 * AT_KSTR + sch * 16) = K0_; *(LAS v4u*)(lds + AT_K0 + bf_ * AT_KB + (skey0 + 32) * AT_KSTR + sch * 16) = K1_; \
            *(LAS v4u*)(lds + AT_V0 + bf_ * AT_VB + skey0 * AT_VSTR + sch * 16) = V0_; *(LAS v4u*)(lds + AT_V0 + bf_ * AT_VB + (skey0 + 32) * AT_VSTR + sch * 16) = V1_; \
            (void)B_; } while (0)
#define AT_SET_S sk0, sk1, sv0, sv1, sbias
#define AT_SET_T tk0, tk1, tv0, tv1, tbias
#define AT_ISSUE_(i_, ...) AT_ISSUE(i_, __VA_ARGS__)
#define AT_WRITE_(i_, ...) AT_WRITE(i_, __VA_ARGS__)
#define AT_BAR() do { asm volatile("s_waitcnt lgkmcnt(0)" ::: "memory"); __builtin_amdgcn_s_barrier(); asm volatile("" ::: "memory"); } while (0)
        for (int s_ = tid; s_ < (qb + 1) * 256; s_ += NTHR) *(LAS float*)(lds + AT_B0 + s_ * 4) = moba ? slope2 * (float)(s_ - t0) : (Fref - FCUM[(size_t)bh * SEQ + s_]) * LOG2E;
        AT_ISSUE_(0, AT_SET_S); AT_WRITE_(0, AT_SET_S);
        AT_ISSUE_(1, AT_SET_S);
        asm volatile("s_waitcnt lgkmcnt(0)" ::: "memory"); __syncthreads();
        for (int idx2 = 0; idx2 < ntiles; idx2 += 2) {
            { const int idx = idx2;
              if (idx + 2 < ntiles) AT_ISSUE_(idx + 2, AT_SET_T);
            const int bp = idx >> 2, ti = idx & 3; const bool own = bp == 0; const int kb = own ? qb : bp - 1;
            const bool lane_sel = own || !moba || ((selmask >> kb) & 1u);
            const bool active = own ? (ti <= (wave >> 1)) : (__any(lane_sel) != 0);
            if (active) {
                const int bf = idx & 1;
                f32x16 s0, s1;
#pragma unroll
                for (int r = 0; r < 16; ++r) { s0[r] = 0.f; s1[r] = 0.f; }
                const LAS unsigned char* Kb = lds + AT_K0 + bf * AT_KB + klane;
#pragma unroll
                for (int ks = 0; ks < 8; ++ks) {
                    const bf16x8 k0 = *(const LAS bf16x8*)(Kb + ks * 32), k1 = *(const LAS bf16x8*)(Kb + 32 * AT_KSTR + ks * 32);
                    const bf16x8 qv = __builtin_bit_cast(bf16x8, qf[ks]);
                    s0 = __builtin_amdgcn_mfma_f32_32x32x16_bf16(k0, qv, s0, 0, 0, 0);
                    s1 = __builtin_amdgcn_mfma_f32_32x32x16_bf16(k1, qv, s1, 0, 0, 0);
                }
                const LAS float* Bb = (const LAS float*)(lds + AT_B0) + kb * 256 + ti * 64 + 4 * hi;
                const float lb = lane_sel ? 0.f : -1e30f;
                float t[32];
#pragma unroll
                for (int g = 0; g < 4; ++g) { const f32x4 b0 = *(const LAS f32x4*)(Bb + 8 * g), b1 = *(const LAS f32x4*)(Bb + 32 + 8 * g);
#pragma unroll
                    for (int r = 0; r < 4; ++r) { t[4 * g + r] = fmaf(s0[4 * g + r], C1, b0[r] + lb); t[16 + 4 * g + r] = fmaf(s1[4 * g + r], C1, b1[r] + lb); } }
                if (own && ti == (wave >> 1)) {
                    const int rloc = 32 * (wave & 1) + q32 - 4 * hi;
#pragma unroll
                    for (int r = 0; r < 16; ++r) { const int kk = (r & 3) + 8 * (r >> 2);
                        t[r] = (kk > rloc) ? -1e30f : t[r]; t[16 + r] = (32 + kk > rloc) ? -1e30f : t[16 + r]; }
                }
                float mx = t[0];
#pragma unroll
                for (int i = 1; i < 32; ++i) mx = fmaxf(mx, t[i]);
                mx = fmaxf(mx, __shfl_xor(mx, 32));
                const float mnew = fmaxf(mrow, mx);
                const float alpha = __builtin_amdgcn_exp2f(mrow - mnew);
                mrow = mnew;
                float psum = 0.f;
#pragma unroll
                for (int i = 0; i < 32; ++i) { t[i] = __builtin_amdgcn_exp2f(t[i] - mnew); psum += t[i]; }
                lrow = lrow * alpha + psum;
                unsigned pk[16];
#pragma unroll
                for (int d = 0; d < 16; ++d) pk[d] = at_cvtpk(t[2 * d], t[2 * d + 1]);
                if (!__all(alpha == 1.0f)) {
#pragma unroll
                    for (int db = 0; db < 4; ++db)
#pragma unroll
                        for (int r = 0; r < 16; ++r) o[db][r] *= alpha;
                }
                const LAS unsigned char* Vb = lds + AT_V0 + bf * AT_VB + vlane;
#pragma unroll
                for (int kk = 0; kk < 4; ++kk) {
                    v4u pw; pw.x = pk[4 * kk + 0]; pw.y = pk[4 * kk + 1]; pw.z = pk[4 * kk + 2]; pw.w = pk[4 * kk + 3];
                    const bf16x8 pb = __builtin_bit_cast(bf16x8, pw);
#pragma unroll
                    for (int db = 0; db < 4; ++db) {
                        const s16x4 lo = at_vtr(Vb + (16 * kk) * AT_VSTR + 64 * db), hi4 = at_vtr(Vb + (16 * kk + 8) * AT_VSTR + 64 * db);
                        bf16x8 va; va[0] = lo[0]; va[1] = lo[1]; va[2] = lo[2]; va[3] = lo[3]; va[4] = hi4[0]; va[5] = hi4[1]; va[6] = hi4[2]; va[7] = hi4[3];
                        o[db] = __builtin_amdgcn_mfma_f32_32x32x16_bf16(va, pb, o[db], 0, 0, 0);
                    }
                }
            }
              if (idx + 1 < ntiles) AT_WRITE_(idx + 1, AT_SET_S);
              AT_BAR(); }
            { const int idx = idx2 + 1;
              if (idx + 2 < ntiles) AT_ISSUE_(idx + 2, AT_SET_S);
            const int bp = idx >> 2, ti = idx & 3; const bool own = bp == 0; const int kb = own ? qb : bp - 1;
            const bool lane_sel = own || !moba || ((selmask >> kb) & 1u);
            const bool active = own ? (ti <= (wave >> 1)) : (__any(lane_sel) != 0);
            if (active) {
                const int bf = idx & 1;
                f32x16 s0, s1;
#pragma unroll
                for (int r = 0; r < 16; ++r) { s0[r] = 0.f; s1[r] = 0.f; }
                const LAS unsigned char* Kb = lds + AT_K0 + bf * AT_KB + klane;
#pragma unroll
                for (int ks = 0; ks < 8; ++ks) {
                    const bf16x8 k0 = *(const LAS bf16x8*)(Kb + ks * 32), k1 = *(const LAS bf16x8*)(Kb + 32 * AT_KSTR + ks * 32);
                    const bf16x8 qv = __builtin_bit_cast(bf16x8, qf[ks]);
                    s0 = __builtin_amdgcn_mfma_f32_32x32x16_bf16(k0, qv, s0, 0, 0, 0);
                    s1 = __builtin_amdgcn_mfma_f32_32x32x16_bf16(k1, qv, s1, 0, 0, 0);
                }
                const LAS float* Bb = (const LAS float*)(lds + AT_B0) + kb * 256 + ti * 64 + 4 * hi;
                const float lb = lane_sel ? 0.f : -1e30f;
                float t[32];
#pragma unroll
                for (int g = 0; g < 4; ++g) { const f32x4 b0 = *(const LAS f32x4*)(Bb + 8 * g), b1 = *(const LAS f32x4*)(Bb + 32 + 8 * g);
#pragma unroll
                    for (int r = 0; r < 4; ++r) { t[4 * g + r] = fmaf(s0[4 * g + r], C1, b0[r] + lb); t[16 + 4 * g + r] = fmaf(s1[4 * g + r], C1, b1[r] + lb); } }
                if (own && ti == (wave >> 1)) {
                    const int rloc = 32 * (wave & 1) + q32 - 4 * hi;
#pragma unroll
                    for (int r = 0; r < 16; ++r) { const int kk = (r & 3) + 8 * (r >> 2);
                        t[r] = (kk > rloc) ? -1e30f : t[r]; t[16 + r] = (32 + kk > rloc) ? -1e30f : t[16 + r]; }
                }
                float mx = t[0];
#pragma unroll
                for (int i = 1; i < 32; ++i) mx = fmaxf(mx, t[i]);
                mx = fmaxf(mx, __shfl_xor(mx, 32));
                const float mnew = fmaxf(mrow, mx);
                const float alpha = __builtin_amdgcn_exp2f(mrow - mnew);
                mrow = mnew;
                float psum = 0.f;
#pragma unroll
                for (int i = 0; i < 32; ++i) { t[i] = __builtin_amdgcn_exp2f(t[i] - mnew); psum += t[i]; }
                lrow = lrow * alpha + psum;
                unsigned pk[16];
#pragma unroll
                for (int d = 0; d < 16; ++d) pk[d] = at_cvtpk(t[2 * d], t[2 * d + 1]);
                if (!__all(alpha == 1.0f)) {
#pragma unroll
                    for (int db = 0; db < 4; ++db)
#pragma unroll
                        for (int r = 0; r < 16; ++r) o[db][r] *= alpha;
                }
                const LAS unsigned char* Vb = lds + AT_V0 + bf * AT_VB + vlane;
#pragma unroll
                for (int kk = 0; kk < 4; ++kk) {
                    v4u pw; pw.x = pk[4 * kk + 0]; pw.y = pk[4 * kk + 1]; pw.z = pk[4 * kk + 2]; pw.w = pk[4 * kk + 3];
                    const bf16x8 pb = __builtin_bit_cast(bf16x8, pw);
#pragma unroll
                    for (int db = 0; db < 4; ++db) {
                        const s16x4 lo = at_vtr(Vb + (16 * kk) * AT_VSTR + 64 * db), hi4 = at_vtr(Vb + (16 * kk + 8) * AT_VSTR + 64 * db);
                        bf16x8 va; va[0] = lo[0]; va[1] = lo[1]; va[2] = lo[2]; va[3] = lo[3]; va[4] = hi4[0]; va[5] = hi4[1]; va[6] = hi4[2]; va[7] = hi4[3];
                        o[db] = __builtin_amdgcn_mfma_f32_32x32x16_bf16(va, pb, o[db], 0, 0, 0);
                    }
                }
            }
              if (idx + 1 < ntiles) AT_WRITE_(idx + 1, AT_SET_T);
              AT_BAR(); }
        }
        __syncthreads();
#undef AT_ISSUE
#undef AT_WRITE
        const float ltot = lrow + __shfl_xor(lrow, 32);
        const float inv = 1.f / ltot;
        bf16* op = MIX + (size_t)(b * SEQ + tw + q32) * DM + (moba ? 0 : 2048) + h * 128 + 4 * hi;
#pragma unroll
        for (int db = 0; db < 4; ++db)
#pragma unroll
            for (int g = 0; g < 4; ++g) { v2u w; w.x = pk2(o[db][4 * g + 0] * inv, o[db][4 * g + 1] * inv); w.y = pk2(o[db][4 * g + 2] * inv, o[db][4 * g + 3] * inv);
                *(v2u*)(op + 32 * db + 8 * g) = w; }
      }
    }
}

__device__ __forceinline__ void ph_requant_mix(const Args& a, int lane, int wave, int G) {
    const bf16* MIX = (const bf16*)(a.ws + WS_MIX); unsigned char* MIXQ = a.ws + WS_MIXQ; float* MSC = (float*)(a.ws + WS_MSC); const float* sko = (const float*)(a.ws + WS_SKOF);
    const int gw = blockIdx.x * NWAVES + wave, NGW = G * NWAVES;
    for (int m = gw; m < NTOK; m += NGW) {
        const v4u* src = (const v4u*)(MIX + (size_t)m * DM) + lane;
        float f[8][8]; float mx = 0.f;
#pragma unroll
        for (int j = 0; j < 8; ++j) { const v4u w = src[64 * j]; const f32x4 s0 = *(const f32x4*)(sko + 8 * lane + 512 * j), s1 = *(const f32x4*)(sko + 8 * lane + 512 * j + 4);
            f[j][0] = bf_lo(w.x) * s0.x; f[j][1] = bf_hi(w.x) * s0.y; f[j][2] = bf_lo(w.y) * s0.z; f[j][3] = bf_hi(w.y) * s0.w;
            f[j][4] = bf_lo(w.z) * s1.x; f[j][5] = bf_hi(w.z) * s1.y; f[j][6] = bf_lo(w.w) * s1.z; f[j][7] = bf_hi(w.w) * s1.w;
#pragma unroll
            for (int e = 0; e < 8; ++e) mx = fmaxf(mx, fabsf(f[j][e])); }
#pragma unroll
        for (int o = 1; o < 64; o <<= 1) mx = fmaxf(mx, __shfl_xor(mx, o));
        const float qs = mx > 0.f ? mx * (1.f / 127.f) : 1.f, qi = 1.f / qs;
        if (lane == 0) MSC[m] = qs;
        v2u* dst = (v2u*)(MIXQ + (size_t)m * DM) + lane;
#pragma unroll
        for (int j = 0; j < 8; ++j) { int q[8];
#pragma unroll
            for (int e = 0; e < 8; ++e) q[e] = __float2int_rn(f[j][e] * qi);
            v2u o; o.x = ((unsigned)q[0] & 255u) | (((unsigned)q[1] & 255u) << 8) | (((unsigned)q[2] & 255u) << 16) | (((unsigned)q[3] & 255u) << 24);
            o.y = ((unsigned)q[4] & 255u) | (((unsigned)q[5] & 255u) << 8) | (((unsigned)q[6] & 255u) << 16) | (((unsigned)q[7] & 255u) << 24);
            dst[64 * j] = o; }
    }
}

__device__ __forceinline__ void ph8_select(const Args& a, LAS unsigned char* lds, int tid, int lane, int wave, int G) {
    const bf16* QP = (const bf16*)(a.ws + WS_QP); const bf16* SKB = (const bf16*)(a.ws + WS_SKB);
    int* EIDX = (int*)(a.ws + WS_EIDX); float* GATE = (float*)(a.ws + WS_GATE);
    LAS float* sc = (LAS float*)(lds + wave * 18944);
    LAS int* lst = (LAS int*)(lds + wave * 18944 + 16896);
    const int h = wave;
    const float* Vf = a.in[16]; float* vscp = (float*)(a.ws + WS_VSC);
    f32x4 cv[16];
#define P8_VISSUE(e_) do { const f32x4* sp_ = (const f32x4*)(Vf + (size_t)(e_) * DM) + lane; _Pragma("unroll") for (int j_ = 0; j_ < 16; ++j_) cv[j_] = sp_[64 * j_]; asm volatile("" ::: "memory"); } while (0)
#define P8_VFINISH(e_) do { float mx_ = 0.f; \
        _Pragma("unroll") for (int j_ = 0; j_ < 16; ++j_) mx_ = fmaxf(mx_, fmaxf(fmaxf(fabsf(cv[j_].x), fabsf(cv[j_].y)), fmaxf(fabsf(cv[j_].z), fabsf(cv[j_].w)))); \
        _Pragma("unroll") for (int o_ = 1; o_ < 64; o_ <<= 1) mx_ = fmaxf(mx_, __shfl_xor(mx_, o_)); \
        const float sc_ = mx_ > 0.f ? mx_ * (1.f / 127.f) : 1.f, inv_ = 1.f / sc_; \
        if (lane == 0) vscp[(e_)] = sc_; \
        unsigned char* dst_ = a.ws + WS_VB + (size_t)(e_) * 128 + ((4 * lane) & 127); \
        _Pragma("unroll") for (int j_ = 0; j_ < 16; ++j_) { \
            const int q0_ = __float2int_rn(cv[j_].x * inv_), q1_ = __float2int_rn(cv[j_].y * inv_), q2_ = __float2int_rn(cv[j_].z * inv_), q3_ = __float2int_rn(cv[j_].w * inv_); \
            *(unsigned*)(dst_ + (size_t)(2 * j_ + (lane >> 5)) * (16384 * 128)) = ((unsigned)q0_ & 255u) | (((unsigned)q1_ & 255u) << 8) | (((unsigned)q2_ & 255u) << 16) | (((unsigned)q3_ & 255u) << 24); } } while (0)
    for (int it = blockIdx.x; it < NTOK / 16; it += G) {
        const int t0 = it * 16; const int ev0 = 4 * (8 * it + wave);
        P8_VISSUE(ev0);
#pragma unroll
        for (int c = 0; c < 2; ++c) {
            bf16x8 A[4];
#pragma unroll
            for (int ks = 0; ks < 4; ++ks) A[ks] = *(const bf16x8*)(QP + (size_t)(t0 + (lane & 15)) * PQ + h * 256 + c * 128 + ks * 32 + (lane >> 4) * 8);
#pragma unroll
            for (int ng = 0; ng < 2; ++ng) {
                bf16x8 Bf[4][4];
#pragma unroll
                for (int n4 = 0; n4 < 4; ++n4)
#pragma unroll
                    for (int ks = 0; ks < 4; ++ks) Bf[n4][ks] = *(const bf16x8*)(SKB + (size_t)((h * 2 + c) * 128 + (4 * ng + n4) * 16 + (lane & 15)) * 128 + ks * 32 + (lane >> 4) * 8);
#pragma unroll
                for (int n4 = 0; n4 < 4; ++n4) { const int nt = 4 * ng + n4; f32x4 acc = {0.f, 0.f, 0.f, 0.f};
#pragma unroll
                    for (int ks = 0; ks < 4; ++ks) acc = __builtin_amdgcn_mfma_f32_16x16x32_bf16(A[ks], Bf[n4][ks], acc, 0, 0, 0);
#pragma unroll
                    for (int i = 0; i < 4; ++i) sc[(c * 16 + (lane >> 4) * 4 + i) * 132 + nt * 16 + (lane & 15)] = acc[i]; }
            }
        }
        P8_VFINISH(ev0); P8_VISSUE(ev0 + 1);
        LDS_WAIT();
        {
            const int row = lane & 31, hh = lane >> 5;
            int L[16];
#pragma unroll
            for (int k = 0; k < 16; ++k) L[k] = (int)0x80000000;
            const LAS f32x4* rp = (const LAS f32x4*)(sc + row * 132 + 64 * hh);
            for (int i = 0; i < 16; ++i) {
                const f32x4 v = rp[i];
#pragma unroll
                for (int e = 0; e < 4; ++e) { int x = tokey((__float_as_uint(v[e]) & ~127u) | (unsigned)(64 * hh + i * 4 + e));
#pragma unroll
                    for (int k = 0; k < 16; ++k) { const int hi = max(L[k], x); x = min(L[k], x); L[k] = hi; } }
            }
            if (hh == 1) {
#pragma unroll
                for (int k = 0; k < 16; ++k) lst[row * 16 + k] = L[k];
            }
            P8_VFINISH(ev0 + 1); P8_VISSUE(ev0 + 2);
            LDS_WAIT();
            if (hh == 0) {
#pragma unroll
                for (int q = 0; q < 16; ++q) { int x = lst[row * 16 + q];
#pragma unroll
                    for (int k = 0; k < 16; ++k) { const int hi = max(L[k], x); x = min(L[k], x); L[k] = hi; } }
            }
            LDS_WAIT();
            if (hh == 0) {
#pragma unroll
                for (int k = 0; k < 16; ++k) lst[row * 16 + k] = L[k];
            }
        }
        P8_VFINISH(ev0 + 2); P8_VISSUE(ev0 + 3);
        LDS_WAIT();
        if (lane < 16) {
            float va[16], vb[16];
#pragma unroll
            for (int i = 0; i < 16; ++i) { const unsigned ia = unkey(lst[lane * 16 + i]) & 127u, ib = unkey(lst[(16 + lane) * 16 + i]) & 127u;
                va[i] = sc[lane * 132 + ia]; vb[i] = sc[(16 + lane) * 132 + ib]; }
            int L2[16];
#pragma unroll
            for (int k = 0; k < 16; ++k) L2[k] = (int)0x80000000;
#pragma unroll
            for (int i = 0; i < 16; ++i)
#pragma unroll
                for (int j = 0; j < 16; ++j)
                    if ((i + 1) * (j + 1) <= 16) { int x = tokey((__float_as_uint(va[i] + vb[j]) & ~255u) | (unsigned)(i * 16 + j));
#pragma unroll
                        for (int k = 0; k < 16; ++k) { const int hi = max(L2[k], x); x = min(L2[k], x); L2[k] = hi; } }
            float sv[16]; int ev[16]; float mxv = -3e38f;
#pragma unroll
            for (int k = 0; k < 16; ++k) { const unsigned code = unkey(L2[k]) & 255u; const int i = code >> 4, j = code & 15;
                const unsigned ea = unkey(lst[lane * 16 + i]) & 127u, eb = unkey(lst[(16 + lane) * 16 + j]) & 127u;
                const float s = sc[lane * 132 + ea] + sc[(16 + lane) * 132 + eb]; sv[k] = s; ev[k] = (int)(ea * 128u + eb); mxv = fmaxf(mxv, s); }
            float sum = 0.f;
#pragma unroll
            for (int k = 0; k < 16; ++k) { sv[k] = __expf(sv[k] - mxv); sum += sv[k]; }
            const float inv = 1.f / sum;
            int* ep = EIDX + (size_t)(t0 + lane) * 128 + h * 16; float* gp = GATE + (size_t)(t0 + lane) * 128 + h * 16;
#pragma unroll
            for (int k = 0; k < 16; ++k) { ep[k] = ev[k]; gp[k] = sv[k] * inv; }
        }
        P8_VFINISH(ev0 + 3);
        LDS_WAIT();
    }
#undef P8_VISSUE
#undef P8_VFINISH
}

__device__ __forceinline__ float gelu_exact(float x) { return 0.5f * x * (1.f + erff(x * 0.70710678118654752f)); }
__device__ __forceinline__ float ub0(unsigned x) { return (float)(x & 255u); }
__device__ __forceinline__ float ub1(unsigned x) { return (float)((x >> 8) & 255u); }
__device__ __forceinline__ float ub2(unsigned x) { return (float)((x >> 16) & 255u); }
__device__ __forceinline__ float ub3(unsigned x) { return (float)(x >> 24); }
template <int CTRL> __device__ __forceinline__ int dpp_i(int v) { return __builtin_amdgcn_update_dpp(0, v, CTRL, 0xf, 0xf, false); }
__device__ __forceinline__ void ph9_gather(const Args& a, LAS unsigned char* lds, int lane, int wave, int G) {
    const unsigned char* H2Q = a.ws + WS_H2Q; const float* HSC = (const float*)(a.ws + WS_HSC); const float* USC = (const float*)(a.ws + WS_USC); const float* VSC = (const float*)(a.ws + WS_VSC);
    const int* EIDX = (const int*)(a.ws + WS_EIDX); const float* GATE = (const float*)(a.ws + WS_GATE);
    const unsigned char* UB = a.ws + WS_UB; const unsigned char* VB = a.ws + WS_VB; const float* mod = (const float*)(a.ws + WS_MOD);
    const int p = lane >> 3, s = lane & 7; const unsigned s16 = (unsigned)s * 16u;
    LAS unsigned* offl = (LAS unsigned*)(lds + wave * 4096) + p;
    LAS float* wl = (LAS float*)(lds + wave * 4096 + 2048) + p;
    const __amdgpu_buffer_rsrc_t rsu = __builtin_amdgcn_make_buffer_rsrc((void*)UB, (short)0, 32 * 16384 * 128, 0x00020000);
    const __amdgpu_buffer_rsrc_t rsv = __builtin_amdgcn_make_buffer_rsrc((void*)VB, (short)0, 32 * 16384 * 128, 0x00020000);
    for (int tg = blockIdx.x; tg < NTOK / 32; tg += G) {
        const int tb = tg * 32 + wave * 4, b = tb / SEQ;
        if (s == 0) { int pl = p; asm volatile("" : "+v"(pl));
#pragma unroll
            for (int tk = 0; tk < 4; ++tk)
#pragma unroll
                for (int i = 0; i < 16; ++i) offl[(tk * 16 + i) * 8] = (unsigned)EIDX[(size_t)(tb + tk) * 128 + 8 * i + pl] * 128u;
        }
        LDS_WAIT();
        int acc[4][16];
#pragma unroll
        for (int tk = 0; tk < 4; ++tk)
#pragma unroll
            for (int i = 0; i < 16; ++i) acc[tk][i] = 0;
#ifndef P9_DUPU
#define P9_DUPU 1
#endif
#ifndef P9_DUPV
#define P9_DUPV 1
#endif
        { v4u uA[16], uB[16], hA, hB;
#define P9_ULOAD(R, HPV, c_, tk_) do { HPV = *(const v4u*)(H2Q + (size_t)(tb + (tk_)) * DM + (c_) * 128 + s * 16); \
            _Pragma("unroll") for (int i_ = 0; i_ < 16; ++i_) R[i_] = __builtin_amdgcn_raw_buffer_load_b128(rsu, (int)(offl[((tk_) * 16 + i_) * 8] + s16), (c_) * (16384 * 128), 0); } while (0)
#define P9_UDOT(R, HPV, tk_) do { _Pragma("unroll") for (int i_ = 0; i_ < 16; ++i_) { int d = acc[tk_][i_]; \
                d = __builtin_amdgcn_sdot4((int)R[i_].x, (int)HPV.x, d, false); d = __builtin_amdgcn_sdot4((int)R[i_].y, (int)HPV.y, d, false); \
                d = __builtin_amdgcn_sdot4((int)R[i_].z, (int)HPV.z, d, false); d = __builtin_amdgcn_sdot4((int)R[i_].w, (int)HPV.w, d, false); acc[tk_][i_] = d; } \
            asm volatile("" : "+v"(acc[tk_][0]), "+v"(acc[tk_][1]), "+v"(acc[tk_][2]), "+v"(acc[tk_][3]), "+v"(acc[tk_][4]), "+v"(acc[tk_][5]), "+v"(acc[tk_][6]), "+v"(acc[tk_][7]), \
                "+v"(acc[tk_][8]), "+v"(acc[tk_][9]), "+v"(acc[tk_][10]), "+v"(acc[tk_][11]), "+v"(acc[tk_][12]), "+v"(acc[tk_][13]), "+v"(acc[tk_][14]), "+v"(acc[tk_][15]) :: "memory"); } while (0)
          P9_ULOAD(uA, hA, 0, 0);
          for (int cc = 0; cc < 32 * P9_DUPU; ++cc) { const int c = cc & 31, cn = (cc + 1) & 31;
            P9_ULOAD(uB, hB, c, 1); P9_UDOT(uA, hA, 0);
            P9_ULOAD(uA, hA, c, 2); P9_UDOT(uB, hB, 1);
            P9_ULOAD(uB, hB, c, 3); P9_UDOT(uA, hA, 2);
            if (cc + 1 < 32 * P9_DUPU) P9_ULOAD(uA, hA, cn, 0);
            P9_UDOT(uB, hB, 3);
          }
#undef P9_ULOAD
#undef P9_UDOT
        }
        LAS unsigned* whl = (LAS unsigned*)(lds + wave * 4096 + 2048);
        float wsc[4];
#pragma unroll
        for (int tk = 0; tk < 4; ++tk) {
            const float hs = HSC[tb + tk]; float wmx = 0.f; float wv[16]; int pg = p; asm volatile("" : "+v"(pg));
#pragma unroll
            for (int i = 0; i < 16; i += 2) { int d0 = acc[tk][i], d1 = acc[tk][i + 1];
                d0 /= P9_DUPU; d1 /= P9_DUPU;
                d0 += dpp_i<0xB1>(d0); d0 += dpp_i<0x4E>(d0); d0 += dpp_i<0x141>(d0);
                d1 += dpp_i<0xB1>(d1); d1 += dpp_i<0x4E>(d1); d1 += dpp_i<0x141>(d1);
                const unsigned e0 = offl[(tk * 16 + i) * 8] >> 7, e1 = offl[(tk * 16 + i + 1) * 8] >> 7;
                const pg8::f32x2 gl = pg8::gelu_pk((pg8::f32x2){(float)d0 * (USC[e0] * hs), (float)d1 * (USC[e1] * hs)});
                const float w0 = GATE[(size_t)(tb + tk) * 128 + 8 * i + pg] * gl.x * VSC[e0], w1 = GATE[(size_t)(tb + tk) * 128 + 8 * (i + 1) + pg] * gl.y * VSC[e1];
                wv[i] = w0; wv[i + 1] = w1; wmx = fmaxf(wmx, fmaxf(fabsf(w0), fabsf(w1))); }
            wmx = fmaxf(wmx, __shfl_xor(wmx, 8)); wmx = fmaxf(wmx, __shfl_xor(wmx, 16)); wmx = fmaxf(wmx, __shfl_xor(wmx, 32));
            const float wsv = wmx > 0.f ? wmx : 1.f, qf = 16256.f / wsv; wsc[tk] = wsv * (1.f / 16256.f);
#pragma unroll
            for (int g = 0; g < 4; ++g) { unsigned ph = 0u, pl = 0u;
#pragma unroll
                for (int q = 0; q < 4; ++q) { const int W = __float2int_rn(wv[4 * g + q] * qf); const int hi = (W + 64) >> 7, lo = W - (hi << 7);
                    ph |= ((unsigned)hi & 255u) << (8 * q); pl |= ((unsigned)lo & 255u) << (8 * q); }
                if (s == 0) { whl[(tk * 4 + g) * 16 + p] = ph; whl[(tk * 4 + g) * 16 + 8 + p] = pl; } }
            asm volatile("" ::: "memory"); }
        LDS_WAIT();
        const float* g2 = mod + (size_t)b * NMOD + 5 * DM;
        LAS float* g2l = (LAS float*)(lds + 32768);
        __syncthreads();
        { const f32x4 t0 = *(const f32x4*)(g2 + 4 * (wave * 64 + lane)), t1 = *(const f32x4*)(g2 + 2048 + 4 * (wave * 64 + lane));
          *(LAS f32x4*)(g2l + 4 * (wave * 64 + lane)) = t0; *(LAS f32x4*)(g2l + 2048 + 4 * (wave * 64 + lane)) = t1; }
        __syncthreads();
        v4u rA[16], rB[16]; v4u xA, xB;
#define P9_VLOAD(R, X, c_, tk_) do { \
            X = (v4u){0u, 0u, 0u, 0u}; \
            if (p < 2) { int lo_ = s * 16 + 8 * p; asm volatile("" : "+v"(lo_)); X = *(const v4u*)((const bf16*)(a.ws + WS_H) + (size_t)(tb + (tk_)) * DM + (c_) * 128 + lo_); } \
            _Pragma("unroll") for (int i_ = 0; i_ < 16; ++i_) R[i_] = __builtin_amdgcn_raw_buffer_load_b128(rsv, (int)(offl[((tk_) * 16 + i_) * 8] + s16), (c_) * (16384 * 128), 0); } while (0)
#define P9_OUT(X, c_, tk_, J0) do { int so_ = s * 16 + (J0); asm volatile("" : "+v"(so_)); float* op = a.out + (size_t)(tb + (tk_)) * DM + (c_) * 128 + so_; \
            const f32x4 ya = {y[(J0) + 0], y[(J0) + 1], y[(J0) + 2], y[(J0) + 3]}, yb = {y[(J0) + 4], y[(J0) + 5], y[(J0) + 6], y[(J0) + 7]}; \
            const f32x4 ga_ = *(const LAS f32x4*)(g2l + (c_) * 128 + so_), gb_ = *(const LAS f32x4*)(g2l + (c_) * 128 + so_ + 4); \
            const f32x4 x0_ = {bf_lo(X.x), bf_hi(X.x), bf_lo(X.y), bf_hi(X.y)}, x1_ = {bf_lo(X.z), bf_hi(X.z), bf_lo(X.w), bf_hi(X.w)}; \
            *(f32x4*)op = x0_ + ga_ * ya; *(f32x4*)(op + 4) = x1_ + gb_ * yb; } while (0)
#define P9_VPROC(R, X, c_, tk_) do { int yh[16], yl[16]; \
            _Pragma("unroll") for (int j = 0; j < 16; ++j) { yh[j] = 0; yl[j] = 0; } \
            _Pragma("unroll") for (int g = 0; g < 4; ++g) { const int wh_ = (int)whl[((tk_) * 4 + g) * 16 + p], wl_ = (int)whl[((tk_) * 4 + g) * 16 + 8 + p]; \
                _Pragma("unroll") for (int dw = 0; dw < 4; ++dw) { const unsigned a_ = R[4 * g][dw], b_ = R[4 * g + 1][dw], c2_ = R[4 * g + 2][dw], d_ = R[4 * g + 3][dw]; \
                    const unsigned t0 = __builtin_amdgcn_perm(b_, a_, 0x05010400u), t1 = __builtin_amdgcn_perm(b_, a_, 0x07030602u), t2 = __builtin_amdgcn_perm(d_, c2_, 0x05010400u), t3 = __builtin_amdgcn_perm(d_, c2_, 0x07030602u); \
                    const int o0 = (int)__builtin_amdgcn_perm(t2, t0, 0x05040100u), o1 = (int)__builtin_amdgcn_perm(t2, t0, 0x07060302u), o2 = (int)__builtin_amdgcn_perm(t3, t1, 0x05040100u), o3 = (int)__builtin_amdgcn_perm(t3, t1, 0x07060302u); \
                    yh[4 * dw + 0] = __builtin_amdgcn_sdot4(o0, wh_, yh[4 * dw + 0], false); yl[4 * dw + 0] = __builtin_amdgcn_sdot4(o0, wl_, yl[4 * dw + 0], false); \
                    yh[4 * dw + 1] = __builtin_amdgcn_sdot4(o1, wh_, yh[4 * dw + 1], false); yl[4 * dw + 1] = __builtin_amdgcn_sdot4(o1, wl_, yl[4 * dw + 1], false); \
                    yh[4 * dw + 2] = __builtin_amdgcn_sdot4(o2, wh_, yh[4 * dw + 2], false); yl[4 * dw + 2] = __builtin_amdgcn_sdot4(o2, wl_, yl[4 * dw + 2], false); \
                    yh[4 * dw + 3] = __builtin_amdgcn_sdot4(o3, wh_, yh[4 * dw + 3], false); yl[4 * dw + 3] = __builtin_amdgcn_sdot4(o3, wl_, yl[4 * dw + 3], false); } } \
            float y[16]; \
            _Pragma("unroll") for (int j = 0; j < 16; ++j) y[j] = (float)(yh[j] * 128 + yl[j]) * wsc[tk_]; \
            _Pragma("unroll") for (int j = 0; j < 16; ++j) { y[j] += dpp_f<0x128, 0xf>(y[j]); y[j] += __shfl_xor(y[j], 16); y[j] += __shfl_xor(y[j], 32); } \
            if (wr_) { if (p == 0) P9_OUT(X, c_, tk_, 0); else if (p == 1) P9_OUT(X, c_, tk_, 8); } \
            asm volatile("" ::: "memory"); } while (0)
        P9_VLOAD(rA, xA, 0, 0);
        for (int cc = 0; cc < 32 * P9_DUPV; ++cc) { const int c = cc & 31, cn = (cc + 1) & 31; const bool wr_ = (cc >= 32 * (P9_DUPV - 1)) || (wsc[0] == 12345.678f);
            P9_VLOAD(rB, xB, c, 1); P9_VPROC(rA, xA, c, 0);
            P9_VLOAD(rA, xA, c, 2); P9_VPROC(rB, xB, c, 1);
            P9_VLOAD(rB, xB, c, 3); P9_VPROC(rA, xA, c, 2);
            if (cc + 1 < 32 * P9_DUPV) P9_VLOAD(rA, xA, cn, 0);
            P9_VPROC(rB, xB, c, 3);
        }
#undef P9_VLOAD
#undef P9_VPROC
#undef P9_OUT
        LDS_WAIT();
    }
}

__device__ __forceinline__ void transpose_item_i8w(const float* W, int ld, int K, unsigned char* WQ, const float* skinv, LAS float* scr, int kb, int n0, int lane) {
    const int k0 = 128 * kb;
    float tv[64];
#pragma unroll
    for (int i = 0; i < 64; ++i) tv[i] = W[(size_t)(k0 + 2 * i + (lane >> 5)) * ld + n0 + (lane & 31)];
#pragma unroll
    for (int i = 0; i < 64; ++i) scr[(2 * i + (lane >> 5)) * 33 + (lane & 31)] = tv[i];
    const int c = lane & 7, nl = lane >> 3;
    float si[16];
#pragma unroll
    for (int q = 0; q < 4; ++q) { const f32x4 t = *(const f32x4*)(skinv + k0 + 16 * c + 4 * q); si[4 * q] = t.x; si[4 * q + 1] = t.y; si[4 * q + 2] = t.z; si[4 * q + 3] = t.w; }
    LDS_WAIT();
#pragma unroll
    for (int jj = 0; jj < 4; ++jj) { const int n = nl + 8 * jj; const LAS float* sp = scr + (16 * c) * 33 + n; v4u o;
#pragma unroll
        for (int q = 0; q < 4; ++q) { const int q0 = __float2int_rn(sp[(4 * q) * 33] * si[4 * q]), q1 = __float2int_rn(sp[(4 * q + 1) * 33] * si[4 * q + 1]), q2 = __float2int_rn(sp[(4 * q + 2) * 33] * si[4 * q + 2]), q3 = __float2int_rn(sp[(4 * q + 3) * 33] * si[4 * q + 3]);
            o[q] = ((unsigned)q0 & 255u) | (((unsigned)q1 & 255u) << 8) | (((unsigned)q2 & 255u) << 16) | (((unsigned)q3 & 255u) << 24); }
        *(v4u*)(WQ + (size_t)(n0 + n) * K + k0 + 16 * c) = o; }
    LDS_WAIT();
}
__device__ __forceinline__ void transpose_item_i8n(const float* W, int ld, int K, unsigned char* WQ, const unsigned* colmax_bits, LAS float* scr, int kb, int n0, int lane) {
    const int k0 = 64 * kb;
    float tv[32];
#pragma unroll
    for (int i = 0; i < 32; ++i) tv[i] = W[(size_t)(k0 + 2 * i + (lane >> 5)) * ld + n0 + (lane & 31)];
#pragma unroll
    for (int i = 0; i < 32; ++i) scr[(2 * i + (lane >> 5)) * 33 + (lane & 31)] = tv[i];
    const int c = lane & 3, nl = lane >> 2;
    LDS_WAIT();
#pragma unroll
    for (int jj = 0; jj < 2; ++jj) { const int n = nl + 16 * jj; const LAS float* sp = scr + (16 * c) * 33 + n; v4u o;
        const float mxv = __uint_as_float(colmax_bits[n0 + n]); const float si = mxv > 0.f ? 127.f / mxv : 1.f;
#pragma unroll
        for (int q = 0; q < 4; ++q) { const int q0 = __float2int_rn(sp[(4 * q) * 33] * si), q1 = __float2int_rn(sp[(4 * q + 1) * 33] * si), q2 = __float2int_rn(sp[(4 * q + 2) * 33] * si), q3 = __float2int_rn(sp[(4 * q + 3) * 33] * si);
            o[q] = ((unsigned)q0 & 255u) | (((unsigned)q1 & 255u) << 8) | (((unsigned)q2 & 255u) << 16) | (((unsigned)q3 & 255u) << 24); }
        *(v4u*)(WQ + (size_t)(n0 + n) * K + k0 + 16 * c) = o; }
    LDS_WAIT();
}
__device__ __forceinline__ void transpose_item_q8(const unsigned char* Wq, int ld, int K, unsigned char* WQ, LAS unsigned char* scr, int kb, int nb, int lane) {
    const int k0 = 128 * kb, n0 = 128 * nb;
    v4u tv[16];
#pragma unroll
    for (int i = 0; i < 16; ++i) tv[i] = *(const v4u*)(Wq + (size_t)(k0 + 8 * i + (lane >> 3)) * ld + n0 + 16 * (lane & 7));
#pragma unroll
    for (int i = 0; i < 16; ++i) { LAS unsigned* d = (LAS unsigned*)(scr + (8 * i + (lane >> 3)) * 132 + 16 * (lane & 7)); d[0] = tv[i].x; d[1] = tv[i].y; d[2] = tv[i].z; d[3] = tv[i].w; }
    LDS_WAIT();
    const int kc = lane & 7, nl = lane >> 3;
#pragma unroll
    for (int jj = 0; jj < 16; ++jj) { const int n = nl + 8 * jj; const LAS unsigned char* sp = scr + (16 * kc) * 132 + n; v4u o;
#pragma unroll
        for (int q = 0; q < 4; ++q) o[q] = (unsigned)sp[(4 * q) * 132] | ((unsigned)sp[(4 * q + 1) * 132] << 8) | ((unsigned)sp[(4 * q + 2) * 132] << 16) | ((unsigned)sp[(4 * q + 3) * 132] << 24);
        *(v4u*)(WQ + (size_t)(n0 + n) * K + k0 + 16 * kc) = o; }
    LDS_WAIT();
}
__device__ __forceinline__ void p1_transpose_win(const Args& a, LAS unsigned char* lds, int lane, int wave, int G) {
    const int gw = blockIdx.x * NWAVES + wave, NGW = G * NWAVES;
    LAS unsigned char* scr = lds + wave * 16896;
    for (int it = gw; it < 3072 + 1024 + 4096; it += NGW) {
        if (it < 3072) transpose_item_q8(a.ws + WS_WINKN, NQKV, DM, a.ws + WS_WINQ, scr, it / 96, it % 96, lane);
        else if (it < 4096) { const int r = it - 3072; transpose_item_q8(a.ws + WS_WOKN, DM, DM, a.ws + WS_WOQ, scr, r / 32, r % 32, lane); }
        else { const int r = it - 4096; transpose_item_i8n(a.in[13], PQ, DM, a.ws + WS_WPQQ, (const unsigned*)(a.ws + WS_PQMAX), (LAS float*)scr, r / 64, 32 * (r % 64), lane); }
    }
    __syncthreads();
}

#ifndef MK_ONE_LAUNCH
#define MK_ONE_LAUNCH 1
#endif
__global__ void __launch_bounds__(NTHR, 2) hymba_fwd(Args a) {
    extern __shared__ __attribute__((aligned(16))) unsigned char lds_raw[];
    LAS unsigned char* lds = (LAS unsigned char*)lds_raw;
    const int tid = threadIdx.x, lane = tid & 63, wave = __builtin_amdgcn_readfirstlane(tid >> 6), G = gridDim.x;
    volatile LAS unsigned* MISC = (volatile LAS unsigned*)(lds + MISC_OFF);
    if (tid < 64) MISC[tid] = 0u;
    __syncthreads();
    const int lo = a.ph_lo, hi = a.ph_hi;
    XcdBarrier bar; bar.bar = (unsigned*)(a.ws + WS_CTL) + CW_BAR; bar.x = 0; bar.st = nullptr;
    if (hi - lo > 1) bar = xcd_barrier_post((unsigned*)(a.ws + WS_CTL) + CW_BAR, MISC + 8);
#define IN(k) (lo <= (k) && (k) < hi)
#define SEAM(k) do { if (IN(k) && IN((k) + 1)) xcd_barrier(bar); } while (0)
    float* mod = (float*)(a.ws + WS_MOD);
    bf16* H = (bf16*)(a.ws + WS_H);

#ifndef DUP_MASK
#define DUP_MASK 0
#endif
#define RUN(k, ...) do { if (IN(k)) { __VA_ARGS__; if ((DUP_MASK >> (k)) & 1) { xcd_barrier(bar); __VA_ARGS__; } SEAM(k); } } while (0)
    RUN(0, ph0_prologue(a, lds, tid, lane, wave, G));
#ifndef P1_DUPT
#define P1_DUPT 0
#endif
#ifndef P1_DUPN
#define P1_DUPN 0
#endif
    RUN(1, { p1_transpose_win(a, lds, lane, wave, G); if (P1_DUPT) p1_transpose_win(a, lds, lane, wave, G);
        if (P1_DUPN) ph_norm<true>(a.in[0], a.in[4], mod + 0 * DM, mod + 1 * DM, H, a.ws + WS_H1Q, (float*)(a.ws + WS_HSC1), (const float*)(a.ws + WS_SKF), (const float*)(a.ws + WS_FGIMG), a.in[6], (float*)(a.ws + WS_LOGF), lds, lane, wave, G);
        ph_norm<true>(a.in[0], a.in[4], mod + 0 * DM, mod + 1 * DM, H, a.ws + WS_H1Q, (float*)(a.ws + WS_HSC1), (const float*)(a.ws + WS_SKF), (const float*)(a.ws + WS_FGIMG), a.in[6], (float*)(a.ws + WS_LOGF), lds, lane, wave, G); });
    RUN(2, { fcum_items(a, lds, tid, lane, wave, G);
        { pg8::Gemm g{(const pg8::bf16_t*)(a.ws + WS_H1Q), (const pg8::bf16_t*)(a.ws + WS_WINQ), NTOK, NQKV, DM / 2}; pg8::StaticOrder S; S.init(NTOK, NQKV, G, (int)blockIdx.x);
          pg8::EpiInProj<true> E{(pg8::bf16_t*)(a.ws + WS_PROJ), NQKV, 0, (const float*)(a.ws + WS_HSC1), (const float*)(a.ws + WS_GT), (float*)(a.ws + WS_KMEAN), (LAS float*)(lds + 131072), EPS};
          pg8::gemm_phase<pg8::EpiInProj<true>, pg8::StaticOrder, true, true, true>(lds, g, S, E); } });
    RUN(3, ph4_attn_mfma(a, lds, tid, lane, wave, G));
    RUN(4, ph_requant_mix(a, lane, wave, G));
    RUN(5, { pg8::Gemm g{(const pg8::bf16_t*)(a.ws + WS_MIXQ), (const pg8::bf16_t*)(a.ws + WS_WOQ), NTOK, DM, DM / 2}; pg8::StaticOrder S; S.init(NTOK, DM, G, (int)blockIdx.x);
        pg8::EpiResGateBf<true> E{a.in[0], (pg8::bf16_t*)(a.ws + WS_H), DM, mod + 2 * DM, SEQ, NMOD, (const float*)(a.ws + WS_MSC)};
        pg8::gemm_phase<pg8::EpiResGateBf<true>, pg8::StaticOrder, true, true, true>(lds, g, S, E); });
    RUN(6, ph_norm<false, false, true>((const float*)(a.ws + WS_H), a.in[12], mod + 3 * DM, mod + 4 * DM, H, a.ws + WS_H2Q, (float*)(a.ws + WS_HSC), nullptr, nullptr, nullptr, nullptr, lds, lane, wave, G));
    RUN(7, { pg8::Gemm g{(const pg8::bf16_t*)(a.ws + WS_H2Q), (const pg8::bf16_t*)(a.ws + WS_WPQQ), NTOK, PQ, DM / 2}; pg8::StaticOrder S; S.init(NTOK, PQ, G, (int)blockIdx.x);
        pg8::EpiBf16RC E{(pg8::bf16_t*)(a.ws + WS_QP), PQ, (const float*)(a.ws + WS_HSC), (const unsigned*)(a.ws + WS_PQMAX)};
        pg8::gemm_phase<pg8::EpiBf16RC, pg8::StaticOrder, true, true, true>(lds, g, S, E); });
    RUN(8, ph8_select(a, lds, tid, lane, wave, G));
    RUN(9, ph9_gather(a, lds, lane, wave, G));
#undef RUN
#undef IN
#undef SEAM
}

extern "C" void kernel_launch(void* const* d_in, const int* in_sizes, int n_in, void* d_out, int out_size, void* d_ws, size_t ws_size, hipStream_t stream) {
    static int grid = 0;
    if (grid == 0) {
        if (n_in != 17 || out_size != NTOK * DM || ws_size < WS_END) { fprintf(stderr, "kernel_launch: unexpected shapes (n_in %d out %d ws %zu)\n", n_in, out_size, ws_size); grid = -1; return; }
        int dev = 0, cus = 0, per_cu = 0;
        if (hipGetDevice(&dev) != hipSuccess || hipDeviceGetAttribute(&cus, hipDeviceAttributeMultiprocessorCount, dev) != hipSuccess) { grid = -1; return; }
        if (hipFuncSetAttribute((const void*)hymba_fwd, hipFuncAttributeMaxDynamicSharedMemorySize, LDS_BYTES) != hipSuccess) { fprintf(stderr, "kernel_launch: hipFuncSetAttribute failed\n"); grid = -1; return; }
        if (hipOccupancyMaxActiveBlocksPerMultiprocessor(&per_cu, (const void*)hymba_fwd, NTHR, LDS_BYTES) != hipSuccess || per_cu < 1)
            fprintf(stderr, "kernel_launch: note: occupancy query reports %d workgroups per CU\n", per_cu);
        (void)hipGetLastError();
        grid = cus;
    }
    if (grid < 0) return;
    if (hipMemsetAsync((char*)d_ws + WS_CTL, 0, ZERO_BYTES, stream) != hipSuccess) { fprintf(stderr, "kernel_launch: memset failed\n"); return; }
    Args a{};
    for (int i = 0; i < 17; ++i) a.in[i] = (const float*)d_in[i];
    a.out = (float*)d_out; a.ws = (unsigned char*)d_ws;
#if MK_ONE_LAUNCH
    a.ph_lo = 0; a.ph_hi = NPH;
    hipLaunchKernelGGL(hymba_fwd, dim3(grid), dim3(NTHR), LDS_BYTES, stream, a);
#else
    for (int p = 0; p < NPH; ++p) { a.ph_lo = p; a.ph_hi = p + 1; hipLaunchKernelGGL(hymba_fwd, dim3(grid), dim3(NTHR), LDS_BYTES, stream, a); }
#endif
}
```

```cpp
#include <hip/hip_runtime.h>
#include <cstdio>
#include <cstdint>
namespace pg8 {
#define PG8_LAS __attribute__((address_space(3)))
typedef unsigned short bf16_t;
typedef short bf16x8 __attribute__((ext_vector_type(8)));
typedef float f32x4 __attribute__((ext_vector_type(4)));
typedef unsigned u32x4 __attribute__((ext_vector_type(4)));
constexpr int BM = 256, BK = 64, HALF = 128, HTB = HALF * BK * 2  , STAGE_BYTES = 8 * HTB, NXCD = 8, WGM = 8;

__host__ __device__ __forceinline__ int lds_byte(int r, int c) { const int st = (r >> 4) * 2 + (c >> 5), rr = r & 15, cc = c & 31, ob = rr * 64 + cc * 2; return st * 1024 + (ob ^ (((ob >> 9) & 1) << 5)); }
__host__ __device__ __forceinline__ void stage_rc(int b, int& R, int& C) { const int st = b / 1024, sb = b % 1024, swz = sb ^ (((sb >> 9) & 1) << 5); R = (st >> 1) * 16 + swz / 64; C = (st & 1) * 32 + (swz % 64) / 2; }
__host__ __device__ __forceinline__ int perm32(int rho) { const int n = rho >> 4, i = rho & 15; return 8 * (i >> 2) + 4 * n + (i & 3); }

struct Unit { int pm, pn; };
struct Gemm { const bf16_t* A; const bf16_t* Bt; int M, N, K; };

struct StaticOrder {
    int nM, nN, nwg, G, c;
    __host__ __device__ void init(int M, int N, int G_, int c_) { nM = M / BM; nN = N / BM; nwg = nM * nN; G = G_; c = c_; }
    __host__ __device__ bool next(int i, Unit& u) const {
        const long L = (long)i * G + c; if (L >= nwg) return false;
        int wgid = (int)L; { const int q = nwg / NXCD, r = nwg % NXCD, xcd = wgid % NXCD, off = wgid / NXCD; wgid = (xcd < r ? xcd * (q + 1) : r * (q + 1) + (xcd - r) * q) + off; }
        const int nig = WGM * nN, gid = wgid / nig, fm = gid * WGM, gsz = (nM - fm) < WGM ? (nM - fm) : WGM;
        u.pm = fm + ((wgid % nig) % gsz); u.pn = (wgid % nig) / gsz; return true;
    }
    __device__ __forceinline__ void a_ready(const Unit&) const {}
    __device__ __forceinline__ void done(const Unit&) const {}
};

__device__ __forceinline__ unsigned cvt_pk_bf16(float lo, float hi) { unsigned r; asm volatile("v_cvt_pk_bf16_f32 %0, %1, %2" : "=v"(r) : "v"(lo), "v"(hi)); return r; }
typedef float f32x2 __attribute__((ext_vector_type(2)));
__device__ __forceinline__ f32x2 gelu_pk(f32x2 v) {
    const f32x2 av = __builtin_elementwise_abs(v), d = av * 0.2316418882f + 1.0f;
    f32x2 t; t.x = __builtin_amdgcn_rcpf(d.x); t.y = __builtin_amdgcn_rcpf(d.y);
    f32x2 q = t * 0.5307027145f + (-0.7265760135f); q = q * t + 0.7107068705f; q = q * t + (-0.142248368f); q = q * t + 0.127414796f; q = q * t;
    const f32x2 s = (v * v) * (-0.72134752044f);
    f32x2 e; e.x = __builtin_amdgcn_exp2f(s.x); e.y = __builtin_amdgcn_exp2f(s.y);
    const f32x2 m = v * (q * e), r = v - m;
    f32x2 o; o.x = v.x < 0.f ? m.x : r.x; o.y = v.y < 0.f ? m.y : r.y; return o;
}

template <int ACT  > struct EpiBf16 {
    static constexpr bool PERM = true, AFTER_DRAIN = false; static_assert(ACT == 0 || ACT == 1, "EpiBf16: ACT is 0 (none) or 1 (gelu_pk)");
    bf16_t* O; int ldc; const float* bias; int split_cols; size_t split_stride; float scale0;
    __device__ __forceinline__ void operator()(const f32x4 (&acc)[2][2][4][2], const Unit& u, int wr, int wc, int fr, int fq) const {
        const int row0 = u.pm * BM + wr * 64 + fr; int colt = u.pn * BM; bf16_t* base = O;
        float sc = 1.f; if (split_cols) { const int t = colt / split_cols; base += (size_t)t * split_stride; colt -= t * split_cols; if (t == 0) sc = scale0; }
        const int col0 = colt + wc * 32 + 8 * fq, bcol0 = u.pn * BM + wc * 32 + 8 * fq;
        f32x4 bv[2][2];
#pragma unroll
        for (int bj = 0; bj < 2; ++bj)
#pragma unroll
            for (int n = 0; n < 2; ++n) bv[bj][n] = bias ? *(const f32x4*)(bias + bcol0 + bj * HALF + 4 * n) : (f32x4){0.f, 0.f, 0.f, 0.f};
#pragma unroll
        for (int ai = 0; ai < 2; ++ai)
#pragma unroll
            for (int m = 0; m < 4; ++m) { bf16_t* rowp = base + (size_t)(row0 + ai * HALF + m * 16) * ldc + col0;
#pragma unroll
                for (int bj = 0; bj < 2; ++bj) { f32x4 v0 = acc[ai][bj][m][0] + bv[bj][0], v1 = acc[ai][bj][m][1] + bv[bj][1];
                    if (ACT == 1) { f32x2 a = gelu_pk((f32x2){v0[0], v0[1]}), b = gelu_pk((f32x2){v0[2], v0[3]}), c = gelu_pk((f32x2){v1[0], v1[1]}), d = gelu_pk((f32x2){v1[2], v1[3]});
                        v0 = (f32x4){a.x, a.y, b.x, b.y}; v1 = (f32x4){c.x, c.y, d.x, d.y}; }
                    v0 = v0 * sc; v1 = v1 * sc; u32x4 w; w.x = cvt_pk_bf16(v0[0], v0[1]); w.y = cvt_pk_bf16(v0[2], v0[3]); w.z = cvt_pk_bf16(v1[0], v1[1]); w.w = cvt_pk_bf16(v1[2], v1[3]);
                    *(u32x4*)(rowp + bj * HALF) = w; } }
    }
};
typedef int i32x4 __attribute__((ext_vector_type(4)));
template <bool I8> struct AccSel { typedef f32x4 type; };
template <> struct AccSel<true> { typedef i32x4 type; };
template <bool I8> struct EpiInProj {
    static constexpr bool PERM = true, AFTER_DRAIN = false;
    typedef typename AccSel<I8>::type acc_t;
    bf16_t* O; int ldc; int col_base; const float* rowscale;
    const float* gtab;
    float* kmean; PG8_LAS float* xs; float eps;
    static __device__ __forceinline__ f32x4 tof(const f32x4& a) { return a; }
    static __device__ __forceinline__ f32x4 tof(const i32x4& a) { return __builtin_convertvector(a, f32x4); }
    __device__ __forceinline__ void pre(const Unit& u, int wr, int fr, float (&rs)[8]) const { const int row0 = u.pm * BM + wr * 64 + fr;
#pragma unroll
        for (int ai = 0; ai < 2; ++ai)
#pragma unroll
            for (int m = 0; m < 4; ++m) rs[ai * 4 + m] = I8 ? rowscale[row0 + ai * HALF + m * 16] : 1.f; }
    __device__ __forceinline__ void operator()(const acc_t (&acc)[2][2][4][2], const Unit& u, int wr, int wc, int fr, int fq, const float (&rsp)[8]) const {
        asm volatile("" : "+v"(fr), "+v"(fq));
        const int colt = col_base + u.pn * BM, kind = colt >> 11;
        const int row0 = u.pm * BM + wr * 64 + fr;
        bf16_t* obase = O + (size_t)row0 * ldc + colt + wc * 32 + 8 * fq;
        if (kind == 2 || kind == 5) {
#pragma unroll
            for (int ai = 0; ai < 2; ++ai)
#pragma unroll
                for (int m = 0; m < 4; ++m) { const float rs = rsp[ai * 4 + m]; bf16_t* rowp = obase + (size_t)(ai * HALF + m * 16) * ldc;
#pragma unroll
                    for (int bj = 0; bj < 2; ++bj) { const f32x4 v0 = tof(acc[ai][bj][m][0]) * rs, v1 = tof(acc[ai][bj][m][1]) * rs;
                        u32x4 w; w.x = cvt_pk_bf16(v0[0], v0[1]); w.y = cvt_pk_bf16(v0[2], v0[3]); w.z = cvt_pk_bf16(v1[0], v1[1]); w.w = cvt_pk_bf16(v1[2], v1[3]);
                        *(u32x4*)(rowp + bj * HALF) = w; } }
            return;
        }
#pragma unroll
        for (int ai = 0; ai < 2; ++ai)
#pragma unroll
            for (int m = 0; m < 4; ++m)
#pragma unroll
                for (int bj = 0; bj < 2; ++bj) { const f32x4 a0 = tof(acc[ai][bj][m][0]), a1 = tof(acc[ai][bj][m][1]);
                    float s = (a0[0] * a0[0] + a0[1] * a0[1]) + (a0[2] * a0[2] + a0[3] * a0[3]) + (a1[0] * a1[0] + a1[1] * a1[1]) + (a1[2] * a1[2] + a1[3] * a1[3]);
                    s += __shfl_xor(s, 16); s += __shfl_xor(s, 32);
                    if (fq == 0) xs[(((wr * 2 + bj) * 128) + ai * 64 + m * 16 + fr) * 4 + wc] = s;
                    asm volatile("" ::: "memory"); }
        asm volatile("s_waitcnt lgkmcnt(0)" ::: "memory"); __builtin_amdgcn_s_barrier(); asm volatile("" ::: "memory");
        if (kind == 1) pass2<true>(acc, rsp, u, colt, kind, row0, obase, wr, wc, fr, fq); else pass2<false>(acc, rsp, u, colt, kind, row0, obase, wr, wc, fr, fq);
    }
    template <bool KM> __device__ __forceinline__ void pass2(const acc_t (&acc)[2][2][4][2], const float (&rsp)[8], const Unit& u, int colt, int kind, int row0, bf16_t* obase, int wr, int wc, int fr, int fq) const {
        const float* gain = gtab + kind * 128;
        const f32x4 gv0 = *(const f32x4*)(gain + wc * 32 + 8 * fq), gv1 = *(const f32x4*)(gain + wc * 32 + 8 * fq + 4);
        f32x4 cs[2][2];
#pragma unroll
        for (int bj = 0; bj < 2; ++bj) { cs[bj][0] = (f32x4){0.f, 0.f, 0.f, 0.f}; cs[bj][1] = cs[bj][0]; }
#pragma unroll
        for (int ai = 0; ai < 2; ++ai)
#pragma unroll
            for (int m = 0; m < 4; ++m) { const float rs = rsp[ai * 4 + m]; bf16_t* rowp = obase + (size_t)(ai * HALF + m * 16) * ldc;
#pragma unroll
                for (int bj = 0; bj < 2; ++bj) {
                    const f32x4 p4 = *(const PG8_LAS f32x4*)(xs + (((wr * 2 + bj) * 128) + ai * 64 + m * 16 + fr) * 4);
                    const float tot = ((p4[0] + p4[1]) + (p4[2] + p4[3])) * (rs * rs);
                    const float mult = rs / sqrtf(tot * (1.0f / 128.0f) + eps);
                    acc_t r0 = acc[ai][bj][m][0], r1 = acc[ai][bj][m][1]; asm volatile("" : "+v"(r0), "+v"(r1));
                    const f32x4 v0 = tof(r0) * mult * gv0, v1 = tof(r1) * mult * gv1;
                    if (KM) { cs[bj][0] += v0; cs[bj][1] += v1; }
                    u32x4 w; w.x = cvt_pk_bf16(v0[0], v0[1]); w.y = cvt_pk_bf16(v0[2], v0[3]); w.z = cvt_pk_bf16(v1[0], v1[1]); w.w = cvt_pk_bf16(v1[2], v1[3]);
                    *(u32x4*)(rowp + bj * HALF) = w; }
                if (KM) asm volatile("" : "+v"(cs[0][0]), "+v"(cs[0][1]), "+v"(cs[1][0]), "+v"(cs[1][1]));
                asm volatile("" ::: "memory"); }
        if (KM) {
            const int b = u.pm >> 3, blk = u.pm & 7, h0 = (colt - 2048) >> 7;
#pragma unroll
            for (int bj = 0; bj < 2; ++bj)
#pragma unroll
                for (int n = 0; n < 2; ++n)
#pragma unroll
                    for (int j = 0; j < 4; ++j) { float c = cs[bj][n][j];
                        c += __shfl_xor(c, 1); c += __shfl_xor(c, 2); c += __shfl_xor(c, 4); c += __shfl_xor(c, 8);
                        if (fr == 0) (void)__hip_atomic_fetch_add(kmean + (((size_t)b * 16 + h0 + bj) * 8 + blk) * 128 + wc * 32 + 8 * fq + 4 * n + j, c * (1.0f / 256.0f), __ATOMIC_RELAXED, __HIP_MEMORY_SCOPE_AGENT); }
        }
    }
};
template <bool I8> struct EpiResGate {
    static constexpr bool PERM = false, AFTER_DRAIN = false;
    typedef typename AccSel<I8>::type acc_t;
    const float* base; float* out; int ldc; const float* gate; int rows_per_batch; int gate_stride; const float* rowscale;
    static __device__ __forceinline__ f32x4 tof(const f32x4& a) { return a; }
    static __device__ __forceinline__ f32x4 tof(const i32x4& a) { return __builtin_convertvector(a, f32x4); }
    __device__ __forceinline__ void operator()(const acc_t (&acc)[2][2][4][2], const Unit& u, int wr, int wc, int fr, int fq) const {
        const int row0 = u.pm * BM + wr * 64 + fr, col0 = u.pn * BM + wc * 32 + 4 * fq;
        const int b = (u.pm * BM) / rows_per_batch;
        f32x4 gv[2][2];
#pragma unroll
        for (int bj = 0; bj < 2; ++bj)
#pragma unroll
            for (int n = 0; n < 2; ++n) gv[bj][n] = *(const f32x4*)(gate + (size_t)b * gate_stride + col0 + bj * HALF + n * 16);
#pragma unroll
        for (int ai = 0; ai < 2; ++ai)
#pragma unroll
            for (int m = 0; m < 4; ++m) { const size_t off = (size_t)(row0 + ai * HALF + m * 16) * ldc + col0; const float rs = I8 ? rowscale[row0 + ai * HALF + m * 16] : 1.f;
#pragma unroll
                for (int bj = 0; bj < 2; ++bj)
#pragma unroll
                    for (int n = 0; n < 2; ++n) { const f32x4 xb = *(const f32x4*)(base + off + bj * HALF + n * 16);
                        *(f32x4*)(out + off + bj * HALF + n * 16) = xb + gv[bj][n] * (tof(acc[ai][bj][m][n]) * rs); } }
    }
};

template <bool I8> struct EpiResGateBf {
    static constexpr bool PERM = true, AFTER_DRAIN = false;
    typedef typename AccSel<I8>::type acc_t;
    const float* base; bf16_t* O; int ldc; const float* gate; int rows_per_batch; int gate_stride; const float* rowscale;
    static __device__ __forceinline__ f32x4 tof(const f32x4& a) { return a; }
    static __device__ __forceinline__ f32x4 tof(const i32x4& a) { return __builtin_convertvector(a, f32x4); }
    __device__ __forceinline__ void pre(const Unit& u, int wr, int fr, float (&rs)[8]) const { const int row0 = u.pm * BM + wr * 64 + fr;
#pragma unroll
        for (int ai = 0; ai < 2; ++ai)
#pragma unroll
            for (int m = 0; m < 4; ++m) rs[ai * 4 + m] = I8 ? rowscale[row0 + ai * HALF + m * 16] : 1.f; }
    __device__ __forceinline__ void operator()(const acc_t (&acc)[2][2][4][2], const Unit& u, int wr, int wc, int fr, int fq, const float (&rsp)[8]) const {
        const int row0 = u.pm * BM + wr * 64 + fr, col0 = u.pn * BM + wc * 32 + 8 * fq;
        const int b = (u.pm * BM) / rows_per_batch;
        f32x4 gv[2][2];
#pragma unroll
        for (int bj = 0; bj < 2; ++bj)
#pragma unroll
            for (int n = 0; n < 2; ++n) gv[bj][n] = *(const f32x4*)(gate + (size_t)b * gate_stride + col0 + bj * HALF + 4 * n);
#pragma unroll
        for (int ai = 0; ai < 2; ++ai)
#pragma unroll
            for (int m = 0; m < 4; ++m) { const size_t off = (size_t)(row0 + ai * HALF + m * 16) * ldc + col0; const float rs = rsp[ai * 4 + m];
                f32x4 xv[2][2];
#pragma unroll
                for (int bj = 0; bj < 2; ++bj) { xv[bj][0] = *(const f32x4*)(base + off + bj * HALF); xv[bj][1] = *(const f32x4*)(base + off + bj * HALF + 4); }
#pragma unroll
                for (int bj = 0; bj < 2; ++bj) { const f32x4 v0 = xv[bj][0] + gv[bj][0] * (tof(acc[ai][bj][m][0]) * rs), v1 = xv[bj][1] + gv[bj][1] * (tof(acc[ai][bj][m][1]) * rs);
                    u32x4 w; w.x = cvt_pk_bf16(v0[0], v0[1]); w.y = cvt_pk_bf16(v0[2], v0[3]); w.z = cvt_pk_bf16(v1[0], v1[1]); w.w = cvt_pk_bf16(v1[2], v1[3]);
                    *(u32x4*)(O + off + bj * HALF) = w; } }
    }
};

struct EpiBf16RC {
    static constexpr bool PERM = true, AFTER_DRAIN = false;
    bf16_t* O; int ldc; const float* rowscale; const unsigned* colmax_bits;
    __device__ __forceinline__ void pre(const Unit& u, int wr, int fr, float (&rs)[8]) const { const int row0 = u.pm * BM + wr * 64 + fr;
#pragma unroll
        for (int ai = 0; ai < 2; ++ai)
#pragma unroll
            for (int m = 0; m < 4; ++m) rs[ai * 4 + m] = rowscale[row0 + ai * HALF + m * 16]; }
    __device__ __forceinline__ void operator()(const i32x4 (&acc)[2][2][4][2], const Unit& u, int wr, int wc, int fr, int fq, const float (&rsp)[8]) const {
        asm volatile("" : "+v"(fr), "+v"(fq));
        const int row0 = u.pm * BM + wr * 64 + fr, col0 = u.pn * BM + wc * 32 + 8 * fq;
        f32x4 cv[2][2];
#pragma unroll
        for (int bj = 0; bj < 2; ++bj)
#pragma unroll
            for (int n = 0; n < 2; ++n) { const u32x4 b = *(const u32x4*)(colmax_bits + col0 + bj * HALF + 4 * n);
                cv[bj][n] = (f32x4){__uint_as_float(b.x), __uint_as_float(b.y), __uint_as_float(b.z), __uint_as_float(b.w)} * (1.0f / 127.0f); }
#pragma unroll
        for (int ai = 0; ai < 2; ++ai)
#pragma unroll
            for (int m = 0; m < 4; ++m) { const float rs = rsp[ai * 4 + m]; bf16_t* rowp = O + (size_t)(row0 + ai * HALF + m * 16) * ldc + col0;
#pragma unroll
                for (int bj = 0; bj < 2; ++bj) { const f32x4 v0 = __builtin_convertvector(acc[ai][bj][m][0], f32x4) * rs * cv[bj][0], v1 = __builtin_convertvector(acc[ai][bj][m][1], f32x4) * rs * cv[bj][1];
                    u32x4 w; w.x = cvt_pk_bf16(v0[0], v0[1]); w.y = cvt_pk_bf16(v0[2], v0[3]); w.z = cvt_pk_bf16(v1[0], v1[1]); w.w = cvt_pk_bf16(v1[2], v1[3]);
                    *(u32x4*)(rowp + bj * HALF) = w; } }
    }
};
__device__ __forceinline__ f32x4 mma_step(f32x4 c, bf16x8 b, bf16x8 a) { return __builtin_amdgcn_mfma_f32_16x16x32_bf16(b, a, c, 0, 0, 0); }
__device__ __forceinline__ i32x4 mma_step(i32x4 c, bf16x8 b, bf16x8 a) { return __builtin_amdgcn_mfma_i32_16x16x64_i8(__builtin_bit_cast(i32x4, b), __builtin_bit_cast(i32x4, a), c, 0, 0, 0); }
template <class Epi, class Sched, bool ALIGN_EPI = false, bool SP2 = false, bool I8 = false>
__device__ __forceinline__ void gemm_phase(PG8_LAS unsigned char* lds, const Gemm g, const Sched& S, const Epi& E) {
    const int tid = threadIdx.x, wid = __builtin_amdgcn_readfirstlane(tid >> 6), lane = tid & 63, wr = wid >> 2, wc = wid & 3, fr = lane & 15, fq = lane >> 4;
    const int K = g.K, nt = K / BK;
    unsigned voffA[2], voffB[2];
#pragma unroll
    for (int i = 0; i < 2; ++i) { int R, C; stage_rc(tid * 16 + i * 8192, R, C); const int Rb = Epi::PERM ? ((R & ~31) + perm32(R & 31)) : R;
        voffA[i] = (unsigned)(R * K + C) * 2u; voffB[i] = (unsigned)(Rb * K + C) * 2u; }
    const size_t kstep = (size_t)(BK * 2);
    const size_t hstep = (size_t)HALF * K * 2;
    const size_t tstep = 2 * hstep;
    const unsigned ldsw = (unsigned)wid * 1024u;
    const int aoff = lds_byte(wr * 64 + fr, fq * 8), boff = lds_byte(wc * 32 + fr, fq * 8);
#define PG8_SA(b, h) (((b) * 2 + (h)) * HTB)
#define PG8_SB(b, h) ((4 + (b) * 2 + (h)) * HTB)
#define PG8_STAGE(bufoff, gbase, voff) do { _Pragma("unroll") for (int _i = 0; _i < 2; ++_i) \
        __builtin_amdgcn_global_load_lds((const unsigned*)((const char*)(gbase) + (voff)[_i]), (PG8_LAS unsigned*)(lds + (bufoff) + ldsw + _i * 8192), 16, 0, 0); } while (0)
#define PG8_LDA(dst, b, h) do { _Pragma("unroll") for (int m = 0; m < 4; ++m) _Pragma("unroll") for (int k = 0; k < 2; ++k) dst[m][k] = *(const PG8_LAS bf16x8*)(lds + PG8_SA(b, h) + aoff + m * 2048 + k * 1024); } while (0)
#define PG8_LDB(dst, b, h) do { _Pragma("unroll") for (int n = 0; n < 2; ++n) _Pragma("unroll") for (int k = 0; k < 2; ++k) dst[n][k] = *(const PG8_LAS bf16x8*)(lds + PG8_SB(b, h) + boff + n * 2048 + k * 1024); } while (0)
#define PG8_MMA(ai, bj, At, Bt) do { __builtin_amdgcn_s_setprio(1); _Pragma("unroll") for (int m = 0; m < 4; ++m) _Pragma("unroll") for (int n = 0; n < 2; ++n) _Pragma("unroll") for (int k = 0; k < 2; ++k) \
        acc[ai][bj][m][n] = mma_step(acc[ai][bj][m][n], Bt[n][k], At[m][k]); __builtin_amdgcn_s_setprio(0); } while (0)
#define PG8_WAIT_V(n) asm volatile("s_waitcnt vmcnt(" #n ")" ::: "memory")
#define PG8_WAIT_L(n) asm volatile("s_waitcnt lgkmcnt(" #n ")" ::: "memory")
#define PG8_BAR __builtin_amdgcn_s_barrier()
#define PG8_SCHED __builtin_amdgcn_sched_barrier(0)
    Unit cur, nxt; int ui = 0;
    if (!S.next(0, cur)) return;
    typedef typename AccSel<I8>::type acc_t;
    acc_t acc[2][2][4][2];
#pragma unroll
    for (int a = 0; a < 2; ++a)
#pragma unroll
        for (int b = 0; b < 2; ++b)
#pragma unroll
            for (int m = 0; m < 4; ++m)
#pragma unroll
                for (int n = 0; n < 2; ++n) acc[a][b][m][n] = (acc_t){0, 0, 0, 0};
    bf16x8 At[4][2], B0[2][2], B1[2][2];
    const char* cA = (const char*)g.A + (size_t)cur.pm * tstep; const char* cB = (const char*)g.Bt + (size_t)cur.pn * tstep;
    S.a_ready(cur);
    if constexpr (SP2) {
        PG8_STAGE(PG8_SB(0, 0), cB, voffB); PG8_STAGE(PG8_SB(0, 1), cB + hstep, voffB); PG8_STAGE(PG8_SA(0, 0), cA, voffA); PG8_STAGE(PG8_SA(0, 1), cA + hstep, voffA);
        if (wr == 1) PG8_BAR;
        PG8_WAIT_V(2); PG8_BAR;
        PG8_STAGE(PG8_SB(1, 0), cB + kstep, voffB); PG8_STAGE(PG8_SA(1, 0), cA + kstep, voffA); PG8_STAGE(PG8_SB(1, 1), cB + hstep + kstep, voffB);
        PG8_WAIT_V(6); PG8_BAR;
    } else {
        PG8_STAGE(PG8_SB(0, 0), cB, voffB); PG8_STAGE(PG8_SA(0, 0), cA, voffA); PG8_STAGE(PG8_SB(0, 1), cB + hstep, voffB); PG8_STAGE(PG8_SA(0, 1), cA + hstep, voffA);
        if (wr == 1) PG8_BAR;
        PG8_WAIT_V(4); PG8_BAR;
        PG8_STAGE(PG8_SB(1, 0), cB + kstep, voffB); PG8_STAGE(PG8_SA(1, 0), cA + kstep, voffA); PG8_STAGE(PG8_SB(1, 1), cB + hstep + kstep, voffB);
        PG8_WAIT_V(6); PG8_BAR;
    }
    for (;;) {
        const bool has_next = S.next(ui + 1, nxt);
        const char* nA = has_next ? (const char*)g.A + (size_t)nxt.pm * tstep : cA; const char* nB = has_next ? (const char*)g.Bt + (size_t)nxt.pn * tstep : cB;
        float rsp[8]; E.pre(cur, wr, fr, rsp);
        for (int t = 0; t < nt; t += 2) {
            const bool last = (t == nt - 2);
            const char* a1 = cA + (size_t)(t + 1) * kstep;
            const char* a2 = last ? nA : cA + (size_t)(t + 2) * kstep; const char* b2 = last ? nB : cB + (size_t)(t + 2) * kstep;
            const char* a3 = a2 + kstep; const char* b3 = b2 + kstep;
            if (last && has_next) S.a_ready(nxt);
            if constexpr (SP2) {
            PG8_LDB(B0, 0, 0); PG8_LDB(B1, 0, 1); PG8_SCHED; PG8_LDA(At, 0, 0); PG8_STAGE(PG8_SA(1, 1), a1 + hstep, voffA);
            PG8_WAIT_V(8); PG8_WAIT_L(0); PG8_BAR; PG8_MMA(0, 0, At, B0); PG8_MMA(0, 1, At, B1); PG8_BAR; PG8_SCHED;
            PG8_LDA(At, 0, 1); PG8_STAGE(PG8_SB(0, 0), b2, voffB); PG8_STAGE(PG8_SB(0, 1), b2 + hstep, voffB); PG8_STAGE(PG8_SA(0, 0), a2, voffA);
            PG8_WAIT_V(8); PG8_WAIT_L(0); PG8_BAR; PG8_MMA(1, 0, At, B0); PG8_MMA(1, 1, At, B1); PG8_BAR; PG8_SCHED;
            PG8_LDB(B0, 1, 0); PG8_LDB(B1, 1, 1); PG8_SCHED; PG8_LDA(At, 1, 0); PG8_STAGE(PG8_SA(0, 1), a2 + hstep, voffA);
            PG8_WAIT_V(8); PG8_WAIT_L(0); PG8_BAR; PG8_MMA(0, 0, At, B0); PG8_MMA(0, 1, At, B1); PG8_BAR; PG8_SCHED;
            PG8_LDA(At, 1, 1); PG8_STAGE(PG8_SB(1, 0), b3, voffB); PG8_STAGE(PG8_SB(1, 1), b3 + hstep, voffB); PG8_STAGE(PG8_SA(1, 0), a3, voffA);
            PG8_WAIT_V(8); PG8_WAIT_L(0); PG8_BAR; PG8_MMA(1, 0, At, B0); PG8_MMA(1, 1, At, B1); PG8_BAR; PG8_SCHED;
            } else {
            PG8_LDB(B0, 0, 0); PG8_SCHED; PG8_LDA(At, 0, 0); PG8_STAGE(PG8_SA(1, 1), a1 + hstep, voffA);
            PG8_WAIT_L(8); PG8_BAR; PG8_WAIT_L(0); PG8_MMA(0, 0, At, B0); PG8_BAR; PG8_SCHED;
            PG8_LDB(B1, 0, 1); PG8_STAGE(PG8_SB(0, 0), b2, voffB);
            PG8_BAR; PG8_WAIT_L(0); PG8_MMA(0, 1, At, B1); PG8_BAR;
            PG8_LDA(At, 0, 1); PG8_STAGE(PG8_SA(0, 0), a2, voffA);
            PG8_BAR; PG8_WAIT_L(0); PG8_MMA(1, 0, At, B0); PG8_BAR; PG8_SCHED;
            PG8_STAGE(PG8_SB(0, 1), b2 + hstep, voffB);
            PG8_WAIT_V(6); PG8_BAR; PG8_MMA(1, 1, At, B1); PG8_BAR;
            PG8_LDB(B0, 1, 0); PG8_SCHED; PG8_LDA(At, 1, 0); PG8_STAGE(PG8_SA(0, 1), a2 + hstep, voffA);
            PG8_WAIT_L(8); PG8_BAR; PG8_WAIT_L(0); PG8_MMA(0, 0, At, B0); PG8_BAR; PG8_SCHED;
            PG8_LDB(B1, 1, 1); PG8_STAGE(PG8_SB(1, 0), b3, voffB);
            PG8_BAR; PG8_WAIT_L(0); PG8_MMA(0, 1, At, B1); PG8_BAR;
            PG8_LDA(At, 1, 1); PG8_STAGE(PG8_SA(1, 0), a3, voffA);
            PG8_BAR; PG8_WAIT_L(0); PG8_MMA(1, 0, At, B0); PG8_BAR; PG8_SCHED;
            PG8_STAGE(PG8_SB(1, 1), b3 + hstep, voffB);
            PG8_WAIT_V(6); PG8_BAR; PG8_MMA(1, 1, At, B1); PG8_BAR;
            }
        }
        if constexpr (ALIGN_EPI) { if (wr == 0) PG8_BAR; }
        if constexpr (!Epi::AFTER_DRAIN) { E(acc, cur, wr, wc, fr, fq, rsp); S.done(cur); }
        if (!has_next) break;
#pragma unroll
        for (int a = 0; a < 2; ++a)
#pragma unroll
            for (int b = 0; b < 2; ++b)
#pragma unroll
                for (int m = 0; m < 4; ++m)
#pragma unroll
                    for (int n = 0; n < 2; ++n) acc[a][b][m][n] = (acc_t){0, 0, 0, 0};
        cur = nxt; cA = nA; cB = nB; ++ui;
        if constexpr (ALIGN_EPI) { if (wr == 1) PG8_BAR; }
    }
    PG8_WAIT_V(0);
    if constexpr (!ALIGN_EPI) { if (wr == 0) PG8_BAR; }
    PG8_BAR;
    if constexpr (Epi::AFTER_DRAIN) { E.fused(acc, cur, wr, wc, fr, fq, lds, wid, lane); S.done(cur); }
#undef PG8_SA
#undef PG8_SB
#undef PG8_STAGE
#undef PG8_LDA
#undef PG8_LDB
#undef PG8_MMA
#undef PG8_WAIT_V
#undef PG8_WAIT_L
#undef PG8_BAR
#undef PG8_SCHED
}
}
#define GAS __attribute__((address_space(1)))
#define LAS __attribute__((address_space(3)))
#define XB_TMO      128
#define XB_XCNT(j)  (256  + 64 * (j))
#define XB_XSUB(j)  (1280 + 64 * (j))
#define XB_XGEN(j)  (2304 + 64 * (j))
#define XB_TOP      3328
#define XB_TOPGEN   3392
#define XCD_BAR_WORDS 3456
#define XB_SPIN_CAP (1u << 18)

__device__ __forceinline__ unsigned xb_ld(unsigned* p)              { return __hip_atomic_load(p, __ATOMIC_RELAXED, __HIP_MEMORY_SCOPE_AGENT); }
__device__ __forceinline__ unsigned xb_add(unsigned* p, unsigned v) { return __hip_atomic_fetch_add(p, v, __ATOMIC_RELAXED, __HIP_MEMORY_SCOPE_AGENT); }
__device__ __forceinline__ unsigned xb_xcc_id() { return (unsigned)__builtin_amdgcn_s_getreg((3 << 11) | 20) & 0xFu; }
#define XB_SPIN(cond, bar) do { unsigned _sp = 0; while (cond) { __builtin_amdgcn_s_sleep(1); \
    if ((++_sp & 255u) == 0u) { if (xb_ld(&(bar)[XB_TMO])) break; if (_sp > XB_SPIN_CAP) { atomicAdd(&(bar)[XB_TMO], 1u); break; } } } } while (0)

struct XcdBarrier {
    unsigned* bar; unsigned x;
    volatile LAS unsigned* st;
};

__device__ __forceinline__ XcdBarrier xcd_barrier_post(unsigned* bar, volatile LAS unsigned* st) {
    XcdBarrier b; b.bar = bar; b.x = xb_xcc_id(); b.st = st;
    if (threadIdx.x == 0) (void)xb_add(&bar[XB_XCNT(b.x)], 1u);
    return b;
}
__device__ __forceinline__ void xcd_barrier_complete(unsigned* bar, unsigned x, unsigned& nloc, unsigned& nx) {
    const unsigned G = gridDim.x * gridDim.y * gridDim.z;
    unsigned sum, cnt, mine, sp = 0u;
    for (;;) {
        sum = 0u; cnt = 0u; mine = 0u;
#pragma unroll
        for (unsigned j = 0; j < 16; ++j) { const unsigned c = xb_ld(&bar[XB_XCNT(j)]); sum += c; cnt += (c > 0u) ? 1u : 0u; mine = (j == x) ? c : mine; }
        if (sum == G) break;
        __builtin_amdgcn_s_sleep(1);
        if ((++sp & 255u) == 0u) { if (xb_ld(&bar[XB_TMO])) break; if (sp > XB_SPIN_CAP) { atomicAdd(&bar[XB_TMO], 1u); break; } }
    }
    nloc = mine > 0u ? mine : 1u; nx = cnt > 0u ? cnt : 1u;
}

__device__ __forceinline__ void xcd_barrier(const XcdBarrier& b) {
    asm volatile("s_waitcnt vmcnt(0)" ::: "memory");
    __syncthreads();
    if (threadIdx.x == 0) {
        unsigned* bar = b.bar;
        __builtin_amdgcn_s_waitcnt(0);
        unsigned nloc = b.st[0], nx = b.st[1];
        if (nloc == 0u) { xcd_barrier_complete(bar, b.x, nloc, nx); b.st[0] = nloc; b.st[1] = nx; }
        const unsigned old = xb_add(&bar[XB_XSUB(b.x)], 1u);
        const unsigned gen = old / nloc;
        if (old + 1u == (gen + 1u) * nloc) {
            __builtin_amdgcn_fence(__ATOMIC_RELEASE, "agent");
            asm volatile("s_waitcnt vmcnt(0)" ::: "memory");
            const unsigned og = xb_add(&bar[XB_TOP], 1u);
            const unsigned tg = og / nx;
            if (og + 1u == (tg + 1u) * nx) xb_add(&bar[XB_TOPGEN], 1u);
            else XB_SPIN(xb_ld(&bar[XB_TOPGEN]) == tg, bar);
            __builtin_amdgcn_fence(__ATOMIC_ACQUIRE, "agent");
            xb_add(&bar[XB_XGEN(b.x)], 1u);
            asm volatile("s_waitcnt vmcnt(0)" ::: "memory");
        } else {
            XB_SPIN(xb_ld(&bar[XB_XGEN(b.x)]) == gen, bar);
            __builtin_amdgcn_fence(__ATOMIC_ACQUIRE, "agent");
            asm volatile("s_waitcnt vmcnt(0)" ::: "memory");
        }
    }
    __syncthreads();
}
constexpr int NB = 4, SEQ = 2048, DM = 4096, NTOK = NB * SEQ, DIN = 12304, NQKV = 12288, HD = 128;
constexpr int NMOD = 6 * DM, PQ = 2048;
constexpr float EPS = 1e-6f;
constexpr int NWAVES = 8, NTHR = 512;
constexpr int NPH = 10;

constexpr size_t MiB = 1u << 20;
constexpr size_t WS_CTL = 0;
constexpr size_t WS_MOD = 1 * MiB;
constexpr size_t WS_KMEAN = 1 * MiB + 512 * 1024;
constexpr size_t ZERO_BYTES = 2 * MiB;
constexpr size_t WS_LOGF = 2 * MiB;
constexpr size_t WS_FCUM = 3 * MiB;
constexpr size_t WS_SKB = 4 * MiB;
constexpr size_t WS_EIDX = 8 * MiB;
constexpr size_t WS_GATE = 12 * MiB;
constexpr size_t WS_WINT = 16 * MiB;
constexpr size_t WS_WOT = 112 * MiB;
constexpr size_t WS_WPQT = 144 * MiB;
constexpr size_t WS_H = 160 * MiB;
constexpr size_t WS_PROJ = 224 * MiB;
constexpr size_t WS_MIX = 416 * MiB;
constexpr size_t WS_QP = 480 * MiB;
constexpr size_t WS_UB = 512 * MiB;
constexpr size_t WS_VB = 640 * MiB;
constexpr size_t WS_H2Q = 768 * MiB;
constexpr size_t WS_WINQ = 920 * MiB;
constexpr size_t WS_H1Q = 840 * MiB;
constexpr size_t WS_WOQ = 872 * MiB;
constexpr size_t WS_MIXQ = 888 * MiB;
constexpr size_t WS_END = 968 * MiB;
constexpr size_t WS_WINKN = 32 * MiB, WS_WOKN = 96 * MiB;
constexpr size_t WS_PQMAX = 1 * MiB + 786432;
constexpr size_t WS_WPQQ = 16 * MiB;
constexpr size_t WS_FGIMG = 6 * MiB;
constexpr size_t WS_SKOINV = 5 * MiB + 393216, WS_SKOF = 5 * MiB + 393216 + 16384, WS_MSC = 5 * MiB + 458752;
constexpr size_t WS_SKINV = 5 * MiB + 196608, WS_SKF = 5 * MiB + 196608 + 16384, WS_HSC1 = 5 * MiB + 262144, WS_GT = 5 * MiB + 327680;
constexpr size_t WS_USC = 5 * MiB, WS_VSC = 5 * MiB + 65536, WS_HSC = 5 * MiB + 131072;
constexpr int CW_BAR = 4096;

constexpr int LDS_BYTES = 163840, MISC_OFF = LDS_BYTES - 256;

#define GAS __attribute__((address_space(1)))
#define LAS __attribute__((address_space(3)))
typedef unsigned short bf16;
typedef unsigned v4u __attribute__((ext_vector_type(4)));
typedef unsigned v2u __attribute__((ext_vector_type(2)));
typedef float f32x4 __attribute__((ext_vector_type(4)));
typedef short bf16x8 __attribute__((ext_vector_type(8)));
#define LDS_WAIT() asm volatile("s_waitcnt lgkmcnt(0)" ::: "memory")

__device__ __forceinline__ unsigned f2bf(float f) { unsigned u = __builtin_bit_cast(unsigned, f); return (u + 0x7fffu + ((u >> 16) & 1u)) >> 16; }
__device__ __forceinline__ unsigned pk2(float lo, float hi) { return f2bf(lo) | (f2bf(hi) << 16); }
__device__ __forceinline__ float bf_lo(unsigned u) { return __uint_as_float(u << 16); }
__device__ __forceinline__ float bf_hi(unsigned u) { return __uint_as_float(u & 0xffff0000u); }
__device__ __forceinline__ float wave_sum(float v) {
#pragma unroll
    for (int o = 1; o < 64; o <<= 1) v += __shfl_xor(v, o);
    return v;
}
__device__ __forceinline__ int tokey(unsigned u) { const int s = (int)u; return s ^ ((s >> 31) & 0x7fffffff); }
__device__ __forceinline__ unsigned unkey(int k) { return (unsigned)(k ^ ((k >> 31) & 0x7fffffff)); }

template <int CTRL, int ROW_MASK> __device__ __forceinline__ float dpp_f(float v) { return __builtin_bit_cast(float, __builtin_amdgcn_update_dpp(0, __builtin_bit_cast(int, v), CTRL, ROW_MASK, 0xf, false)); }
#define WAVE_SUM63(v) do { v += dpp_f<0xB1, 0xf>(v); v += dpp_f<0x4E, 0xf>(v); v += dpp_f<0x141, 0xf>(v); v += dpp_f<0x140, 0xf>(v); v += dpp_f<0x142, 0xa>(v); v += dpp_f<0x143, 0xc>(v); } while (0)

typedef __bf16 bf16x2_t __attribute__((ext_vector_type(2)));
__device__ __forceinline__ float dot2bf(unsigned a, unsigned b, float acc) { return __builtin_amdgcn_fdot2_f32_bf16(__builtin_bit_cast(bf16x2_t, a), __builtin_bit_cast(bf16x2_t, b), acc, false); }
struct Args { const float* in[17]; float* out; unsigned char* ws; int ph_lo, ph_hi; };

__device__ __forceinline__ void transpose_item(const float* W, int ld, int K, bf16* WT, LAS float* scr, int kb, int nb, int lane) {
    const int k0 = 64 * kb, n0 = 32 * nb;
    float tv[32];
#pragma unroll
    for (int i = 0; i < 32; ++i) tv[i] = W[(size_t)(k0 + 2 * i + (lane >> 5)) * ld + n0 + (lane & 31)];
#pragma unroll
    for (int i = 0; i < 32; ++i) scr[(2 * i + (lane >> 5)) * 33 + (lane & 31)] = tv[i];
    LDS_WAIT();
    const int c = lane & 7;
#pragma unroll
    for (int j = 0; j < 4; ++j) { const int n = (lane >> 3) + 8 * j; const LAS float* s = scr + (8 * c) * 33 + n;
        v4u o; o.x = pk2(s[0 * 33], s[1 * 33]); o.y = pk2(s[2 * 33], s[3 * 33]); o.z = pk2(s[4 * 33], s[5 * 33]); o.w = pk2(s[6 * 33], s[7 * 33]);
        *(v4u*)(WT + (size_t)(n0 + n) * K + k0 + 8 * c) = o; }
    LDS_WAIT();
}

__device__ __forceinline__ void transpose_item_i8(const float* W, int ld, int K, unsigned char* WQ, const float* skinv, LAS float* scr, int kb, int n_src0, int n_dst0, int lane) {
    const int k0 = 64 * kb;
    float tv[32];
#pragma unroll
    for (int i = 0; i < 32; ++i) tv[i] = W[(size_t)(k0 + 2 * i + (lane >> 5)) * ld + n_src0 + (lane & 31)];
#pragma unroll
    for (int i = 0; i < 32; ++i) scr[(2 * i + (lane >> 5)) * 33 + (lane & 31)] = tv[i];
    const int c = lane & 3, nl = lane >> 2;
    float si[16];
#pragma unroll
    for (int q = 0; q < 4; ++q) { const f32x4 t = *(const f32x4*)(skinv + k0 + 16 * c + 4 * q); si[4 * q] = t.x; si[4 * q + 1] = t.y; si[4 * q + 2] = t.z; si[4 * q + 3] = t.w; }
    LDS_WAIT();
#pragma unroll
    for (int jj = 0; jj < 2; ++jj) { const int n = nl + 16 * jj; const LAS float* sp = scr + (16 * c) * 33 + n; v4u o;
#pragma unroll
        for (int q = 0; q < 4; ++q) { const int q0 = __float2int_rn(sp[(4 * q) * 33] * si[4 * q]), q1 = __float2int_rn(sp[(4 * q + 1) * 33] * si[4 * q + 1]), q2 = __float2int_rn(sp[(4 * q + 2) * 33] * si[4 * q + 2]), q3 = __float2int_rn(sp[(4 * q + 3) * 33] * si[4 * q + 3]);
            o[q] = ((unsigned)q0 & 255u) | (((unsigned)q1 & 255u) << 8) | (((unsigned)q2 & 255u) << 16) | (((unsigned)q3 & 255u) << 24); }
        *(v4u*)(WQ + (size_t)(n_dst0 + n) * K + k0 + 16 * c) = o; }
    LDS_WAIT();
}

__device__ __forceinline__ void ph0_prologue(const Args& a, LAS unsigned char* lds, int tid, int lane, int wave, int G) {
    const float* c = a.in[1]; const float* w_ada = a.in[2]; const float* b_ada = a.in[3];
    float* mod = (float*)(a.ws + WS_MOD);
    LAS float* cs = (LAS float*)lds;
    LAS f32x4* red = (LAS f32x4*)(lds + 65536);
    for (int i = tid; i < 4 * DM; i += NTHR) { const float cv = c[i]; cs[i] = cv / (1.f + __expf(-cv)); }
    __syncthreads();
#ifndef P0_DUPG
#define P0_DUPG 1
#endif
#ifndef P0_DUPC
#define P0_DUPC 1
#endif
    const int kg = tid / 24, cq = tid % 24;
    for (int rep_ = 0; rep_ < P0_DUPG; ++rep_)
    for (int it = blockIdx.x; it < 256; it += G) {
        if (tid < 504) {
            const float* wp = w_ada + (size_t)kg * NMOD + it * 96 + cq * 4;
            f32x4 acc0 = {0.f, 0.f, 0.f, 0.f}, acc1 = acc0, acc2 = acc0, acc3 = acc0;
            const int nrow = (DM - kg + 20) / 21;
#pragma unroll 8
            for (int i = 0; i < nrow; ++i) {
                const f32x4 w = *(const f32x4*)(wp + (size_t)(21 * i) * NMOD);
                const int k = kg + 21 * i;
                acc0 += cs[k] * w; acc1 += cs[DM + k] * w; acc2 += cs[2 * DM + k] * w; acc3 += cs[3 * DM + k] * w;
            }
            red[(kg * 4 + 0) * 24 + cq] = acc0; red[(kg * 4 + 1) * 24 + cq] = acc1; red[(kg * 4 + 2) * 24 + cq] = acc2; red[(kg * 4 + 3) * 24 + cq] = acc3;
        }
        __syncthreads();
        if (tid < 96) { const int b = tid / 24, q = tid % 24;
            f32x4 s = *(const f32x4*)(b_ada + it * 96 + q * 4);
            for (int g = 0; g < 21; ++g) s += red[(g * 4 + b) * 24 + q];
            *(f32x4*)(mod + (size_t)b * NMOD + it * 96 + q * 4) = s; }
        __syncthreads();
    }
    const int gw = blockIdx.x * NWAVES + wave, NGW = G * NWAVES;
    LAS float* scr = (LAS float*)(lds + 81920 + wave * 8448);
    { unsigned* pqmax = (unsigned*)(a.ws + WS_PQMAX);
      for (int it = gw; it < 2048; it += NGW) { const int cg = it & 63, slab = it >> 6; const float* wp = a.in[13] + (size_t)(slab * 128 + (lane >> 5)) * PQ + 32 * cg + (lane & 31); float mx = 0.f;
#pragma unroll 16
          for (int i = 0; i < 64; ++i) mx = fmaxf(mx, fabsf(wp[(size_t)(2 * i) * PQ]));
          mx = fmaxf(mx, __shfl_xor(mx, 32));
          if (lane < 32) atomicMax(pqmax + 32 * cg + lane, __float_as_uint(mx)); } }
    if (blockIdx.x == 0 && tid < 128) { float* gt = (float*)(a.ws + WS_GT); gt[tid] = a.in[7][tid]; gt[128 + tid] = a.in[8][tid]; gt[256 + tid] = 0.f; gt[384 + tid] = a.in[9][tid]; gt[512 + tid] = a.in[10][tid]; gt[640 + tid] = 0.f; }
    { const f32x4* sk = (const f32x4*)a.in[14]; v4u* skb = (v4u*)(a.ws + WS_SKB);
      for (int i = blockIdx.x * NTHR + tid; i < 32768; i += G * NTHR) { const f32x4 p = sk[2 * i], q = sk[2 * i + 1];
          v4u o; o.x = pk2(p.x, p.y); o.y = pk2(p.z, p.w); o.z = pk2(q.x, q.y); o.w = pk2(q.z, q.w); skb[i] = o; } }
    for (int ci = blockIdx.x * NTHR + tid; ci < 8192; ci += G * NTHR) { const int g = ci >> 3, q = ci & 7, kp = q >> 2, cq = q & 3, k = 4 * g + 2 * kp; const float* w_in = a.in[5];
        const f32x4 w0 = *(const f32x4*)(w_in + (size_t)k * DIN + NQKV + 4 * cq), w1 = *(const f32x4*)(w_in + (size_t)(k + 1) * DIN + NQKV + 4 * cq);
        v4u o; o.x = pk2(w0.x, w1.x); o.y = pk2(w0.y, w1.y); o.z = pk2(w0.z, w1.z); o.w = pk2(w0.w, w1.w);
        *(v4u*)(a.ws + WS_FGIMG + 128 * g + 16 * (q ^ ((g >> 1) & 7))) = o; }
    { const float* Uf = a.in[15]; const float* Vf = a.in[16]; float* usc = (float*)(a.ws + WS_USC); float* vsc = (float*)(a.ws + WS_VSC);
      for (int rep_ = 0; rep_ < P0_DUPC; ++rep_) {
      f32x4 vn[16];
      { const int r0 = gw; const f32x4* s0 = (const f32x4*)((r0 >= 16384 ? Vf : Uf) + (size_t)(r0 & 16383) * DM) + lane;
#pragma unroll
        for (int j = 0; j < 16; ++j) vn[j] = r0 < 16384 ? s0[64 * j] : (f32x4){0.f, 0.f, 0.f, 0.f}; }
      for (int r = gw; r < 16384; r += NGW) {
          const bool isv = false; const int e = r;
          f32x4 v[16]; float mx = 0.f;
#pragma unroll
          for (int j = 0; j < 16; ++j) { v[j] = vn[j]; mx = fmaxf(mx, fmaxf(fmaxf(fabsf(v[j].x), fabsf(v[j].y)), fmaxf(fabsf(v[j].z), fabsf(v[j].w)))); }
          { const int rn = r + NGW; if (rn < 16384) { const f32x4* sn = (const f32x4*)((rn >= 16384 ? Vf : Uf) + (size_t)(rn & 16383) * DM) + lane;
#pragma unroll
              for (int j = 0; j < 16; ++j) vn[j] = sn[64 * j]; } }
#pragma unroll
          for (int o = 1; o < 64; o <<= 1) mx = fmaxf(mx, __shfl_xor(mx, o));
          const float sc = mx > 0.f ? mx * (1.f / 127.f) : 1.f, inv = 1.f / sc;
          if (lane == 0) (isv ? vsc : usc)[e] = sc;
          unsigned char* dst = a.ws + (isv ? WS_VB : WS_UB) + (size_t)e * 128 + ((4 * lane) & 127);
          const int bias = isv ? 128 : 0;
#pragma unroll
          for (int j = 0; j < 16; ++j) {
              const int q0 = __float2int_rn(v[j].x * inv) + bias, q1 = __float2int_rn(v[j].y * inv) + bias, q2 = __float2int_rn(v[j].z * inv) + bias, q3 = __float2int_rn(v[j].w * inv) + bias;
              const unsigned pk = ((unsigned)q0 & 255u) | (((unsigned)q1 & 255u) << 8) | (((unsigned)q2 & 255u) << 16) | (((unsigned)q3 & 255u) << 24);
              *(unsigned*)(dst + (size_t)(2 * j + (lane >> 5)) * (16384 * 128)) = pk; }
      } } }
    { float* skinv = (float*)(a.ws + WS_SKOINV); float* skf = (float*)(a.ws + WS_SKOF); unsigned char* dq = a.ws + WS_WOKN;
      for (int k = gw; k < DM; k += NGW) {
          const f32x4* src = (const f32x4*)(a.in[11] + (size_t)k * DM) + lane; f32x4 v[16]; float mx = 0.f;
#pragma unroll
          for (int j = 0; j < 16; ++j) { v[j] = src[64 * j]; mx = fmaxf(mx, fmaxf(fmaxf(fabsf(v[j].x), fabsf(v[j].y)), fmaxf(fabsf(v[j].z), fabsf(v[j].w)))); }
#pragma unroll
          for (int o = 1; o < 64; o <<= 1) mx = fmaxf(mx, __shfl_xor(mx, o));
          const float sc = mx > 0.f ? mx * (1.f / 127.f) : 1.f, inv = 1.f / sc;
          if (lane == 0) { skf[k] = sc; skinv[k] = inv; }
          unsigned* dp = (unsigned*)(dq + (size_t)k * DM) + lane;
#pragma unroll
          for (int j = 0; j < 16; ++j) { const int q0 = __float2int_rn(v[j].x * inv), q1 = __float2int_rn(v[j].y * inv), q2 = __float2int_rn(v[j].z * inv), q3 = __float2int_rn(v[j].w * inv);
              dp[64 * j] = ((unsigned)q0 & 255u) | (((unsigned)q1 & 255u) << 8) | (((unsigned)q2 & 255u) << 16) | (((unsigned)q3 & 255u) << 24); } } }
    { float* skinv = (float*)(a.ws + WS_SKINV); float* skf = (float*)(a.ws + WS_SKF); unsigned char* dq = a.ws + WS_WINKN;
      for (int k = gw; k < DM; k += NGW) {
          const f32x4* src = (const f32x4*)(a.in[5] + (size_t)k * DIN) + lane; f32x4 v[48]; float mx = 0.f;
#pragma unroll
          for (int j = 0; j < 48; ++j) v[j] = src[64 * j];
#pragma unroll
          for (int j = 0; j < 48; ++j) mx = fmaxf(mx, fmaxf(fmaxf(fabsf(v[j].x), fabsf(v[j].y)), fmaxf(fabsf(v[j].z), fabsf(v[j].w))));
#pragma unroll
          for (int o = 1; o < 64; o <<= 1) mx = fmaxf(mx, __shfl_xor(mx, o));
          const float sc = mx > 0.f ? mx * (1.f / 127.f) : 1.f, inv = 1.f / sc;
          if (lane == 0) { skf[k] = sc; skinv[k] = inv; }
          unsigned* dp = (unsigned*)(dq + (size_t)k * NQKV) + lane;
#pragma unroll
          for (int j = 0; j < 48; ++j) { const int q0 = __float2int_rn(v[j].x * inv), q1 = __float2int_rn(v[j].y * inv), q2 = __float2int_rn(v[j].z * inv), q3 = __float2int_rn(v[j].w * inv);
              dp[64 * j] = ((unsigned)q0 & 255u) | (((unsigned)q1 & 255u) << 8) | (((unsigned)q2 & 255u) << 16) | (((unsigned)q3 & 255u) << 24); } } }
}

template <bool FG, bool WH = true, bool XB = false>
__device__ __forceinline__ void ph_norm(const float* xin, const float* gnorm, const float* sh, const float* sc, bf16* H, unsigned char* H2Q, float* HSC, const float* qcol,
                                        const float* w_in, const float* b_f, float* logf, LAS unsigned char* lds, int lane, int wave, int G) {
    const int gw = blockIdx.x * NWAVES + wave, NGW = G * NWAVES;
    const LAS unsigned char* wfl = lds;
    if (FG) {
        const v4u* img = (const v4u*)w_in; v4u t[16];
#pragma unroll
        for (int i = 0; i < 16; ++i) t[i] = img[threadIdx.x + NTHR * i];
#pragma unroll
        for (int i = 0; i < 16; ++i) *(LAS v4u*)(lds + 16 * (threadIdx.x + NTHR * i)) = t[i];
        __syncthreads();
    }
    for (int m = gw; m < NTOK; m += NGW) {
        int ln = lane; asm volatile("" : "+v"(ln));
        const int b = m / SEQ;
        const f32x4* xr = (const f32x4*)(xin + (size_t)m * DM) + ln;
        f32x4 v[16]; float ss = 0.f;
#pragma unroll
        for (int j = 0; j < 16; ++j) { if (XB) { const v2u t = ((const v2u*)((const bf16*)xin + (size_t)m * DM) + ln)[64 * j]; v[j] = (f32x4){bf_lo(t.x), bf_hi(t.x), bf_lo(t.y), bf_hi(t.y)}; } else v[j] = xr[64 * j];
            ss += (v[j].x * v[j].x + v[j].y * v[j].y) + (v[j].z * v[j].z + v[j].w * v[j].w); }
        ss = wave_sum(ss);
        const float rstd = 1.0f / sqrtf(ss * (1.f / DM) + EPS);
        v2u* ho = (v2u*)(H + (size_t)m * DM) + ln; float hmx = 0.f;
#pragma unroll
        for (int j = 0; j < 16; ++j) { const int col = 4 * ln + 256 * j;
            const f32x4 g = *(const f32x4*)(gnorm + col), s1 = *(const f32x4*)(sc + (size_t)b * NMOD + col), s0 = *(const f32x4*)(sh + (size_t)b * NMOD + col);
            const f32x4 hv = v[j] * rstd * g * (1.f + s1) + s0;
            if (!FG && WH) { v2u o; o.x = pk2(hv.x, hv.y); o.y = pk2(hv.z, hv.w); ho[64 * j] = o; }
            v[j] = hv;
            const f32x4 hq = FG ? hv * *(const f32x4*)(qcol + col) : hv;
            hmx = fmaxf(hmx, fmaxf(fmaxf(fabsf(hq.x), fabsf(hq.y)), fmaxf(fabsf(hq.z), fabsf(hq.w))));
            if (j == 7) asm volatile("" ::: "memory"); }
        {
#pragma unroll
            for (int o = 1; o < 64; o <<= 1) hmx = fmaxf(hmx, __shfl_xor(hmx, o));
            const float qs = hmx > 0.f ? hmx * (1.f / 127.f) : 1.f, qi = 1.f / qs;
            if (ln == 0) HSC[m] = qs;
            int lq = ln;
            unsigned* qo = (unsigned*)(H2Q + (size_t)m * DM) + lq;
            asm volatile("" ::: "memory");
            f32x4 qc[16];
#pragma unroll
            for (int j = 0; j < 16; ++j) qc[j] = FG ? *(const f32x4*)(qcol + 4 * ln + 256 * j) : (f32x4){1.f, 1.f, 1.f, 1.f};
#pragma unroll
            for (int j = 0; j < 16; ++j) { const f32x4 hq = v[j] * qc[j] * qi;
                const int q0 = __float2int_rn(hq.x), q1 = __float2int_rn(hq.y), q2 = __float2int_rn(hq.z), q3 = __float2int_rn(hq.w);
                qo[64 * j] = ((unsigned)q0 & 255u) | (((unsigned)q1 & 255u) << 8) | (((unsigned)q2 & 255u) << 16) | (((unsigned)q3 & 255u) << 24); }
        }
        if (FG) {
            float fa[16];
#pragma unroll
            for (int c = 0; c < 16; ++c) fa[c] = 0.f;
#pragma unroll
            for (int j = 0; j < 16; ++j) { const int g = ln + 64 * j; const LAS unsigned char* gp = wfl + 128 * g; const int sw = (g >> 1) & 7;
#pragma unroll
                for (int kp = 0; kp < 2; ++kp) { const unsigned hpk = pg8::cvt_pk_bf16(v[j][2 * kp], v[j][2 * kp + 1]);
#pragma unroll
                    for (int cq = 0; cq < 4; ++cq) { const v4u w = *(const LAS v4u*)(gp + 16 * ((4 * kp + cq) ^ sw));
                        fa[4 * cq + 0] = dot2bf(w.x, hpk, fa[4 * cq + 0]); fa[4 * cq + 1] = dot2bf(w.y, hpk, fa[4 * cq + 1]); fa[4 * cq + 2] = dot2bf(w.z, hpk, fa[4 * cq + 2]); fa[4 * cq + 3] = dot2bf(w.w, hpk, fa[4 * cq + 3]); } }
                asm volatile("" ::: "memory"); }
            float z = 0.f;
#pragma unroll
            for (int c = 0; c < 16; ++c) { float t = fa[c]; WAVE_SUM63(t); const float tot = __builtin_bit_cast(float, __builtin_amdgcn_readlane(__builtin_bit_cast(int, t), 63)); z = (ln == c) ? tot : z; }
            { int ll = ln;
              if (ll < 16) { z += b_f[ll]; logf[((size_t)b * 16 + ll) * SEQ + (m % SEQ)] = fminf(z, 0.f) - log1pf(__expf(-fabsf(z))); } }
        }
    }
}

template <bool FG>
__device__ __forceinline__ void ph_norm2(const float* xin, const float* gnorm, const float* sh, const float* sc, bf16* H, unsigned char* H2Q, float* HSC, const float* qcol,
                                        const float* w_in, const float* b_f, float* logf, LAS unsigned char* lds, int lane, int wave, int G) {
    const int gw = blockIdx.x * NWAVES + wave, NGW = G * NWAVES;
    const LAS unsigned char* wfl = lds;
    if (FG) {
        for (int ci = threadIdx.x; ci < 8192; ci += NTHR) { const int g = ci >> 3, q = ci & 7, kp = q >> 2, cq = q & 3, k = 4 * g + 2 * kp;
            const f32x4 w0 = *(const f32x4*)(w_in + (size_t)k * DIN + NQKV + 4 * cq), w1 = *(const f32x4*)(w_in + (size_t)(k + 1) * DIN + NQKV + 4 * cq);
            v4u o; o.x = pk2(w0.x, w1.x); o.y = pk2(w0.y, w1.y); o.z = pk2(w0.z, w1.z); o.w = pk2(w0.w, w1.w);
            *(LAS v4u*)(lds + 128 * g + 16 * (q ^ ((g >> 1) & 7))) = o; }
        __syncthreads();
    }
    for (int mp = gw; mp < NTOK / 2; mp += NGW) {
        const int m0 = 2 * mp, b = m0 / SEQ;
        f32x4 v[2][16]; float rstd[2];
#pragma unroll
        for (int r = 0; r < 2; ++r) { const f32x4* xr = (const f32x4*)(xin + (size_t)(m0 + r) * DM) + lane; float ss = 0.f;
#pragma unroll
            for (int j = 0; j < 16; ++j) { v[r][j] = xr[64 * j]; ss += (v[r][j].x * v[r][j].x + v[r][j].y * v[r][j].y) + (v[r][j].z * v[r][j].z + v[r][j].w * v[r][j].w); }
            ss = wave_sum(ss); rstd[r] = 1.0f / sqrtf(ss * (1.f / DM) + EPS); }
        float hmx[2] = {0.f, 0.f};
#pragma unroll
        for (int j = 0; j < 16; ++j) { const int col = 4 * lane + 256 * j;
            const f32x4 g = *(const f32x4*)(gnorm + col), s1 = *(const f32x4*)(sc + (size_t)b * NMOD + col), s0 = *(const f32x4*)(sh + (size_t)b * NMOD + col);
            const f32x4 ga = g * (1.f + s1);
            f32x4 qc = {1.f, 1.f, 1.f, 1.f}; if (FG) qc = *(const f32x4*)(qcol + col);
#pragma unroll
            for (int r = 0; r < 2; ++r) { const f32x4 hv = v[r][j] * rstd[r] * ga + s0;
                v2u o; o.x = pk2(hv.x, hv.y); o.y = pk2(hv.z, hv.w); ((v2u*)(H + (size_t)(m0 + r) * DM) + lane)[64 * j] = o;
                v[r][j] = hv;
                const f32x4 hq = hv * qc;
                hmx[r] = fmaxf(hmx[r], fmaxf(fmaxf(fabsf(hq.x), fabsf(hq.y)), fmaxf(fabsf(hq.z), fabsf(hq.w)))); }
            if (j & 1) asm volatile("" ::: "memory"); }
        {
            float qi[2];
#pragma unroll
            for (int r = 0; r < 2; ++r) {
#pragma unroll
                for (int o = 1; o < 64; o <<= 1) hmx[r] = fmaxf(hmx[r], __shfl_xor(hmx[r], o));
                const float qs = hmx[r] > 0.f ? hmx[r] * (1.f / 127.f) : 1.f; qi[r] = 1.f / qs;
                if (lane == 0) HSC[m0 + r] = qs; }
#pragma unroll
            for (int j = 0; j < 16; ++j) { f32x4 qc = {1.f, 1.f, 1.f, 1.f}; if (FG) qc = *(const f32x4*)(qcol + 4 * lane + 256 * j);
#pragma unroll
                for (int r = 0; r < 2; ++r) { const f32x4 hq = v[r][j] * qc * qi[r];
                    const int q0 = __float2int_rn(hq.x), q1 = __float2int_rn(hq.y), q2 = __float2int_rn(hq.z), q3 = __float2int_rn(hq.w);
                    ((unsigned*)(H2Q + (size_t)(m0 + r) * DM) + lane)[64 * j] = ((unsigned)q0 & 255u) | (((unsigned)q1 & 255u) << 8) | (((unsigned)q2 & 255u) << 16) | (((unsigned)q3 & 255u) << 24); }
                if (j & 1) asm volatile("" ::: "memory"); }
        }
    }
}

__device__ __forceinline__ void fcum_items(const Args& a, LAS unsigned char* lds, int tid, int lane, int wave, int G) {
    const float* LOGF = (const float*)(a.ws + WS_LOGF); float* FCUM = (float*)(a.ws + WS_FCUM);
    LAS float* wt = (LAS float*)(lds + 16384);
    for (int bh = blockIdx.x; bh < 64; bh += G) {
        f32x4 v = ((const f32x4*)(LOGF + (size_t)bh * SEQ))[tid];
        v.y += v.x; v.z += v.y; v.w += v.z; const float tot = v.w;
        float sc = tot;
#pragma unroll
        for (int o = 1; o < 64; o <<= 1) { const float t = __shfl_up(sc, o); if (lane >= o) sc += t; }
        __syncthreads();
        if (lane == 63) wt[wave] = sc;
        __syncthreads();
        float base = 0.f; for (int w = 0; w < wave; ++w) base += wt[w];
        const float excl = base + sc - tot;
        v.x += excl; v.y += excl; v.z += excl; v.w += excl;
        ((f32x4*)(FCUM + (size_t)bh * SEQ))[tid] = v;
    }
    __syncthreads();
}

__device__ __forceinline__ void ph4_attn_naive(const Args& a, LAS unsigned char* lds, int tid, int lane, int wave, int G) {
    const bf16* PROJ = (const bf16*)(a.ws + WS_PROJ); const float* KMEAN = (const float*)(a.ws + WS_KMEAN); const float* FCUM = (const float*)(a.ws + WS_FCUM);
    bf16* MIX = (bf16*)(a.ws + WS_MIX);
    LAS bf16* Ks = (LAS bf16*)lds; LAS bf16* Vs = (LAS bf16*)(lds + 16384); LAS float* Fs = (LAS float*)(lds + 32768);
    const int qi = tid >> 3, dg = tid & 7;
    const float scale = 0.08838834764831845f;
    for (int it = blockIdx.x; it < 4096; it += G) {
        const int qt = 31 - (it >> 7), rest = it & 127; const bool moba = rest < 64; const int bh = rest & 63, b = bh >> 4, h = bh & 15;
        const int t = qt * 64 + qi, qblk = qt >> 2;
        const int qc = moba ? 0 : 6144, kc = moba ? 2048 : 8192, vc = moba ? 4096 : 10240;
        float q[16];
        { const v4u* qp = (const v4u*)(PROJ + (size_t)(b * SEQ + t) * NQKV + qc + h * 128 + dg * 16); const v4u w0 = qp[0], w1 = qp[1];
          q[0] = bf_lo(w0.x); q[1] = bf_hi(w0.x); q[2] = bf_lo(w0.y); q[3] = bf_hi(w0.y); q[4] = bf_lo(w0.z); q[5] = bf_hi(w0.z); q[6] = bf_lo(w0.w); q[7] = bf_hi(w0.w);
          q[8] = bf_lo(w1.x); q[9] = bf_hi(w1.x); q[10] = bf_lo(w1.y); q[11] = bf_hi(w1.y); q[12] = bf_lo(w1.z); q[13] = bf_hi(w1.z); q[14] = bf_lo(w1.w); q[15] = bf_hi(w1.w);
#pragma unroll
          for (int i = 0; i < 16; ++i) q[i] *= scale; }
        unsigned selmask = 0u;
        if (moba) {
            float gate[8];
#pragma unroll
            for (int n = 0; n < 8; ++n) { float d = 0.f;
                if (n < qblk) { const float* km = KMEAN + ((size_t)bh * 8 + n) * 128 + dg * 16;
#pragma unroll
                    for (int i = 0; i < 16; ++i) d += q[i] * km[i]; }
                d += __shfl_xor(d, 1); d += __shfl_xor(d, 2); d += __shfl_xor(d, 4);
                gate[n] = (n < qblk) ? d : -1e30f; }
            if (qblk <= 3) selmask = (1u << qblk) - 1u;
            else {
#pragma unroll
                for (int r = 0; r < 3; ++r) { float bv = -3e38f; int bi = 0;
#pragma unroll
                    for (int n = 0; n < 8; ++n) if (gate[n] > bv) { bv = gate[n]; bi = n; }
                    selmask |= 1u << bi;
#pragma unroll
                    for (int n = 0; n < 8; ++n) if (n == bi) gate[n] = -3e38f; }
            }
        }
        float mx = -1e30f, l = 0.f, o[16];
#pragma unroll
        for (int i = 0; i < 16; ++i) o[i] = 0.f;
        const float slope = exp2f(-0.5f * (float)(h + 1));
        const float Ft = moba ? 0.f : FCUM[(size_t)bh * SEQ + t];
        for (int kt = 0; kt <= qt; ++kt) {
            const int blk = kt >> 2;
            __syncthreads();
            for (int i = tid; i < 1024; i += NTHR) { const int key = i >> 4, ch = i & 15; const size_t g = (size_t)(b * SEQ + kt * 64 + key) * NQKV + h * 128 + ch * 8;
                ((LAS v4u*)Ks)[i] = *(const v4u*)(PROJ + g + kc); ((LAS v4u*)Vs)[i] = *(const v4u*)(PROJ + g + vc); }
            if (!moba && tid < 64) Fs[tid] = FCUM[(size_t)bh * SEQ + kt * 64 + tid];
            __syncthreads();
            const bool need = moba ? ((blk == qblk) || ((selmask >> blk) & 1u)) : true;
            if (__any(need)) {
                for (int j = 0; j < 64; ++j) {
                    const int s = kt * 64 + j;
                    const LAS v4u* kp = (const LAS v4u*)(Ks + j * 128 + dg * 16); const v4u k0 = kp[0], k1 = kp[1];
                    float d = q[0] * bf_lo(k0.x) + q[1] * bf_hi(k0.x) + q[2] * bf_lo(k0.y) + q[3] * bf_hi(k0.y) + q[4] * bf_lo(k0.z) + q[5] * bf_hi(k0.z) + q[6] * bf_lo(k0.w) + q[7] * bf_hi(k0.w)
                            + q[8] * bf_lo(k1.x) + q[9] * bf_hi(k1.x) + q[10] * bf_lo(k1.y) + q[11] * bf_hi(k1.y) + q[12] * bf_lo(k1.z) + q[13] * bf_hi(k1.z) + q[14] * bf_lo(k1.w) + q[15] * bf_hi(k1.w);
                    d += __shfl_xor(d, 1); d += __shfl_xor(d, 2); d += __shfl_xor(d, 4);
                    const bool valid = need && (s <= t);
                    const float logit = moba ? d - slope * (float)(t - s) : d + Ft - Fs[j];
                    if (valid) {
                        if (logit > mx) { const float al = __expf(mx - logit); l *= al;
#pragma unroll
                            for (int i = 0; i < 16; ++i) o[i] *= al;
                            mx = logit; }
                        const float p = __expf(logit - mx); l += p;
                        const LAS v4u* vp = (const LAS v4u*)(Vs + j * 128 + dg * 16); const v4u v0 = vp[0], v1 = vp[1];
                        o[0] += p * bf_lo(v0.x); o[1] += p * bf_hi(v0.x); o[2] += p * bf_lo(v0.y); o[3] += p * bf_hi(v0.y); o[4] += p * bf_lo(v0.z); o[5] += p * bf_hi(v0.z); o[6] += p * bf_lo(v0.w); o[7] += p * bf_hi(v0.w);
                        o[8] += p * bf_lo(v1.x); o[9] += p * bf_hi(v1.x); o[10] += p * bf_lo(v1.y); o[11] += p * bf_hi(v1.y); o[12] += p * bf_lo(v1.z); o[13] += p * bf_hi(v1.z); o[14] += p * bf_lo(v1.w); o[15] += p * bf_hi(v1.w);
                    }
                }
            }
        }
        const float inv = 1.f / l;
        v4u o0, o1; o0.x = pk2(o[0] * inv, o[1] * inv); o0.y = pk2(o[2] * inv, o[3] * inv); o0.z = pk2(o[4] * inv, o[5] * inv); o0.w = pk2(o[6] * inv, o[7] * inv);
        o1.x = pk2(o[8] * inv, o[9] * inv); o1.y = pk2(o[10] * inv, o[11] * inv); o1.z = pk2(o[12] * inv, o[13] * inv); o1.w = pk2(o[14] * inv, o[15] * inv);
        v4u* op = (v4u*)(MIX + (size_t)(b * SEQ + t) * DM + (moba ? 0 : 2048) + h * 128 + dg * 16); op[0] = o0; op[1] = o1;
    }
}

typedef float f32x16 __attribute__((ext_vector_type(16)));
typedef short s16x4 __attribute__((ext_vector_type(4)));
constexpr int AT_KSTR = 272, AT_VSTR = 320;
constexpr int AT_K0 = 0, AT_KB = 64 * AT_KSTR, AT_V0 = 2 * AT_KB, AT_VB = 64 * AT_VSTR, AT_B0 = AT_V0 + 2 * AT_VB, AT_BB = 256;
__device__ __forceinline__ s16x4 at_vtr(const LAS unsigned char* p) { return __builtin_bit_cast(s16x4, __builtin_amdgcn_ds_read_tr16_b64_v4i16((LAS s16x4*)p)); }
__device__ __forceinline__ unsigned at_cvtpk(float lo, float hi) { unsigned r; asm("v_cvt_pk_bf16_f32 %0, %1, %2" : "=v"(r) : "v"(lo), "v"(hi)); return r; }

__device__ __forceinline__ void ph4_attn_mfma(const Args& a, LAS unsigned char* lds, int tid, int lane, int wave, int G) {
    const bf16* PROJ = (const bf16*)(a.ws + WS_PROJ); const float* KMEAN = (const float*)(a.ws + WS_KMEAN); const float* FCUM = (const float*)(a.ws + WS_FCUM);
    bf16* MIX = (bf16*)(a.ws + WS_MIX);
    const int q32 = lane & 31, hi = lane >> 5;
    const float C1 = 0.08838834764831845f * 1.4426950408889634f, LOG2E = 1.4426950408889634f;
    const int vlane = (4 * hi + ((lane & 15) >> 2)) * AT_VSTR + (16 * ((lane >> 4) & 1) + 4 * (lane & 3)) * 2;
    const int klane = q32 * AT_KSTR + hi * 16;
    for (int pi = blockIdx.x; pi < 512; pi += G) {
      for (int half = 0; half < 2; ++half) {
        const int khb = pi >> 2, jq = pi & 3;
        const int qb = half == 0 ? 7 - jq : jq;
        const bool moba = khb < 64; const int bh = khb & 63, b = bh >> 4, h = bh & 15;
        const int qc = moba ? 0 : 6144, kc = moba ? 2048 : 8192, vc = moba ? 4096 : 10240;
        const int t0 = qb * 256, tw = t0 + 32 * wave;
        const bf16* pbase = PROJ + (size_t)(b * SEQ) * NQKV + h * 128;
        v4u qf[8];
        { const bf16* qp = pbase + (size_t)(tw + q32) * NQKV + qc + 8 * hi;
#pragma unroll
          for (int ks = 0; ks < 8; ++ks) qf[ks] = *(const v4u*)(qp + 16 * ks); }
        unsigned selmask = 0u;
        if (moba && qb > 0) {
            float gate[8];
#pragma unroll
            for (int n = 0; n < 8; ++n) { float d = 0.f;
                if (n < qb) { const float* km = KMEAN + ((size_t)bh * 8 + n) * 128 + 8 * hi;
#pragma unroll
                    for (int ks = 0; ks < 8; ++ks) { const f32x4 k0 = *(const f32x4*)(km + 16 * ks), k1 = *(const f32x4*)(km + 16 * ks + 4); const v4u w = qf[ks];
                        d += bf_lo(w.x) * k0.x + bf_hi(w.x) * k0.y + bf_lo(w.y) * k0.z + bf_hi(w.y) * k0.w + bf_lo(w.z) * k1.x + bf_hi(w.z) * k1.y + bf_lo(w.w) * k1.z + bf_hi(w.w) * k1.w; } }
                d += __shfl_xor(d, 32);
                gate[n] = (n < qb) ? d : -1e30f; }
            if (qb <= 3) selmask = (1u << qb) - 1u;
            else {
#pragma unroll
                for (int r = 0; r < 3; ++r) { float bv = -3e38f; int bi = 0;
#pragma unroll
                    for (int n = 0; n < 8; ++n) if (gate[n] > bv) { bv = gate[n]; bi = n; }
                    selmask |= 1u << bi;
#pragma unroll
                    for (int n = 0; n < 8; ++n) if (n == bi) gate[n] = -3e38f; }
            }
        }
        const float slope2 = exp2f(-0.5f * (float)(h + 1)) * LOG2E;
        const float Fref = moba ? 0.f : FCUM[(size_t)bh * SEQ + t0];
        float mrow = -1e30f, lrow = 0.f;
        f32x16 o[4];
#pragma unroll
        for (int db = 0; db < 4; ++db)
#pragma unroll
            for (int r = 0; r < 16; ++r) o[db][r] = 0.f;
        const int ntiles = 4 * (qb + 1);
        v4u sk0 = {0u, 0u, 0u, 0u}, sk1 = sk0, sv0 = sk0, sv1 = sk0, tk0 = sk0, tk1 = sk0, tv0 = sk0, tv1 = sk0; float sbias = 0.f, tbias = 0.f;
        const int skey0 = tid >> 4, sch = tid & 15;
#define AT_ISSUE(idx_, K0_, K1_, V0_, V1_, B_) do { const int bp_ = (idx_) >> 2, ti_ = (idx_) & 3; const int kb_ = bp_ == 0 ? qb : bp_ - 1; const int key0_ = kb_ * 256 + ti_ * 64; \
            const bf16* g0_ = pbase + (size_t)(key0_ + skey0) * NQKV + sch * 8; const bf16* g1_ = g0_ + (size_t)32 * NQKV; \
            K0_ = *(const v4u*)(g0_ + kc); K1_ = *(const v4u*)(g1_ + kc); V0_ = *(const v4u*)(g0_ + vc); V1_ = *(const v4u*)(g1_ + vc); \
            (void)B_; } while (0)
#define AT_WRITE(idx_, K0_, K1_, V0_, V1_, B_) do { const int bf_ = (idx_) & 1; \
            *(LAS v4u*)(lds + AT_K0 + bf_ * AT_KB + skey0 * AT_KSTR + sch * 16) = K0_; *(LAS v4u*)(lds + AT_K0 + bf_ * AT_KB + (skey0 + 32) * AT_KSTR + sch * 16) = K1_; \
            *(LAS v4u*)(lds + AT_V0 + bf_ * AT_VB + skey0 * AT_VSTR + sch * 16) = V0_; *(LAS v4u*)(lds + AT_V0 + bf_ * AT_VB + (skey0 + 32) * AT_VSTR + sch * 16) = V1_; \
            (void)B_; } while (0)
#define AT_SET_S sk0, sk1, sv0, sv1, sbias
#define AT_SET_T tk0, tk1, tv0, tv1, tbias
#define AT_ISSUE_(i_, ...) AT_ISSUE(i_, __VA_ARGS__)
#define AT_WRITE_(i_, ...) AT_WRITE(i_, __VA_ARGS__)
#define AT_BAR() do { asm volatile("s_waitcnt lgkmcnt(0)" ::: "memory"); __builtin_amdgcn_s_barrier(); asm volatile("" ::: "memory"); } while (0)
        for (int s_ = tid; s_ < (qb + 1) * 256; s_ += NTHR) *(LAS float*)(lds + AT_B0 + s_ * 4) = moba ? slope2 * (float)(s_ - t0) : (Fref - FCUM[(size_t)bh * SEQ + s_]) * LOG2E;
        AT_ISSUE_(0, AT_SET_S); AT_WRITE_(0, AT_SET_S);
        AT_ISSUE_(1, AT_SET_S);
        asm volatile("s_waitcnt lgkmcnt(0)" ::: "memory"); __syncthreads();
        for (int idx2 = 0; idx2 < ntiles; idx2 += 2) {
            { const int idx = idx2;
              if (idx + 2 < ntiles) AT_ISSUE_(idx + 2, AT_SET_T);
            const int bp = idx >> 2, ti = idx & 3; const bool own = bp == 0; const int kb = own ? qb : bp - 1;
            const bool lane_sel = own || !moba || ((selmask >> kb) & 1u);
            const bool active = own ? (ti <= (wave >> 1)) : (__any(lane_sel) != 0);
            if (active) {
                const int bf = idx & 1;
                f32x16 s0, s1;
#pragma unroll
                for (int r = 0; r < 16; ++r) { s0[r] = 0.f; s1[r] = 0.f; }
                const LAS unsigned char* Kb = lds + AT_K0 + bf * AT_KB + klane;
#pragma unroll
                for (int ks = 0; ks < 8; ++ks) {
                    const bf16x8 k0 = *(const LAS bf16x8*)(Kb + ks * 32), k1 = *(const LAS bf16x8*)(Kb + 32 * AT_KSTR + ks * 32);
                    const bf16x8 qv = __builtin_bit_cast(bf16x8, qf[ks]);
                    s0 = __builtin_amdgcn_mfma_f32_32x32x16_bf16(k0, qv, s0, 0, 0, 0);
                    s1 = __builtin_amdgcn_mfma_f32_32x32x16_bf16(k1, qv, s1, 0, 0, 0);
                }
                const LAS float* Bb = (const LAS float*)(lds + AT_B0) + kb * 256 + ti * 64 + 4 * hi;
                float t[32];
#pragma unroll
                for (int g = 0; g < 4; ++g) { const f32x4 b0 = *(const LAS f32x4*)(Bb + 8 * g), b1 = *(const LAS f32x4*)(Bb + 32 + 8 * g);
#pragma unroll
                    for (int r = 0; r < 4; ++r) { t[4 * g + r] = fmaf(s0[4 * g + r], C1, b0[r]); t[16 + 4 * g + r] = fmaf(s1[4 * g + r], C1, b1[r]); } }
                if (own && ti == (wave >> 1)) {
                    const int rloc = 32 * (wave & 1) + q32 - 4 * hi;
#pragma unroll
                    for (int r = 0; r < 16; ++r) { const int kk = (r & 3) + 8 * (r >> 2);
                        t[r] = (kk > rloc) ? -1e30f : t[r]; t[16 + r] = (32 + kk > rloc) ? -1e30f : t[16 + r]; }
                }
                float mx = t[0];
#pragma unroll
                for (int i = 1; i < 32; ++i) mx = fmaxf(mx, t[i]);
                mx = lane_sel ? mx : -1e30f;
                mx = fmaxf(mx, __shfl_xor(mx, 32));
                const float mnew = fmaxf(mrow, mx);
                const float alpha = __builtin_amdgcn_exp2f(mrow - mnew);
                mrow = mnew;
                const float msub = lane_sel ? mnew : 1e30f;
                float psum = 0.f;
#pragma unroll
                for (int i = 0; i < 32; ++i) { t[i] = __builtin_amdgcn_exp2f(t[i] - msub); psum += t[i]; }
                lrow = lrow * alpha + psum;
                unsigned pk[16];
#pragma unroll
                for (int d = 0; d < 16; ++d) pk[d] = at_cvtpk(t[2 * d], t[2 * d + 1]);
                if (!__all(alpha == 1.0f)) {
#pragma unroll
                    for (int db = 0; db < 4; ++db)
#pragma unroll
                        for (int r = 0; r < 16; ++r) o[db][r] *= alpha;
                }
                const LAS unsigned char* Vb = lds + AT_V0 + bf * AT_VB + vlane;
#pragma unroll
                for (int kk = 0; kk < 4; ++kk) {
                    v4u pw; pw.x = pk[4 * kk + 0]; pw.y = pk[4 * kk + 1]; pw.z = pk[4 * kk + 2]; pw.w = pk[4 * kk + 3];
                    const bf16x8 pb = __builtin_bit_cast(bf16x8, pw);
#pragma unroll
                    for (int db = 0; db < 4; ++db) {
                        const s16x4 lo = at_vtr(Vb + (16 * kk) * AT_VSTR + 64 * db), hi4 = at_vtr(Vb + (16 * kk + 8) * AT_VSTR + 64 * db);
                        bf16x8 va; va[0] = lo[0]; va[1] = lo[1]; va[2] = lo[2]; va[3] = lo[3]; va[4] = hi4[0]; va[5] = hi4[1]; va[6] = hi4[2]; va[7] = hi4[3];
                        o[db] = __builtin_amdgcn_mfma_f32_32x32x16_bf16(va, pb, o[db], 0, 0, 0);
                    }
                }
            }
              if (idx + 1 < ntiles) AT_WRITE_(idx + 1, AT_SET_S);
              AT_BAR(); }
            { const int idx = idx2 + 1;
              if (idx + 2 < ntiles) AT_ISSUE_(idx + 2, AT_SET_S);
            const int bp = idx >> 2, ti = idx & 3; const bool own = bp == 0; const int kb = own ? qb : bp - 1;
            const bool lane_sel = own || !moba || ((selmask >> kb) & 1u);
            const bool active = own ? (ti <= (wave >> 1)) : (__any(lane_sel) != 0);
            if (active) {
                const int bf = idx & 1;
                f32x16 s0, s1;
#pragma unroll
                for (int r = 0; r < 16; ++r) { s0[r] = 0.f; s1[r] = 0.f; }
                const LAS unsigned char* Kb = lds + AT_K0 + bf * AT_KB + klane;
#pragma unroll
                for (int ks = 0; ks < 8; ++ks) {
                    const bf16x8 k0 = *(const LAS bf16x8*)(Kb + ks * 32), k1 = *(const LAS bf16x8*)(Kb + 32 * AT_KSTR + ks * 32);
                    const bf16x8 qv = __builtin_bit_cast(bf16x8, qf[ks]);
                    s0 = __builtin_amdgcn_mfma_f32_32x32x16_bf16(k0, qv, s0, 0, 0, 0);
                    s1 = __builtin_amdgcn_mfma_f32_32x32x16_bf16(k1, qv, s1, 0, 0, 0);
                }
                const LAS float* Bb = (const LAS float*)(lds + AT_B0) + kb * 256 + ti * 64 + 4 * hi;
                float t[32];
#pragma unroll
                for (int g = 0; g < 4; ++g) { const f32x4 b0 = *(const LAS f32x4*)(Bb + 8 * g), b1 = *(const LAS f32x4*)(Bb + 32 + 8 * g);
#pragma unroll
                    for (int r = 0; r < 4; ++r) { t[4 * g + r] = fmaf(s0[4 * g + r], C1, b0[r]); t[16 + 4 * g + r] = fmaf(s1[4 * g + r], C1, b1[r]); } }
                if (own && ti == (wave >> 1)) {
                    const int rloc = 32 * (wave & 1) + q32 - 4 * hi;
#pragma unroll
                    for (int r = 0; r < 16; ++r) { const int kk = (r & 3) + 8 * (r >> 2);
                        t[r] = (kk > rloc) ? -1e30f : t[r]; t[16 + r] = (32 + kk > rloc) ? -1e30f : t[16 + r]; }
                }
                float mx = t[0];
#pragma unroll
                for (int i = 1; i < 32; ++i) mx = fmaxf(mx, t[i]);
                mx = lane_sel ? mx : -1e30f;
                mx = fmaxf(mx, __shfl_xor(mx, 32));
                const float mnew = fmaxf(mrow, mx);
                const float alpha = __builtin_amdgcn_exp2f(mrow - mnew);
                mrow = mnew;
                const float msub = lane_sel ? mnew : 1e30f;
                float psum = 0.f;
#pragma unroll
                for (int i = 0; i < 32; ++i) { t[i] = __builtin_amdgcn_exp2f(t[i] - msub); psum += t[i]; }
                lrow = lrow * alpha + psum;
                unsigned pk[16];
#pragma unroll
                for (int d = 0; d < 16; ++d) pk[d] = at_cvtpk(t[2 * d], t[2 * d + 1]);
                if (!__all(alpha == 1.0f)) {
#pragma unroll
                    for (int db = 0; db < 4; ++db)
#pragma unroll
                        for (int r = 0; r < 16; ++r) o[db][r] *= alpha;
                }
                const LAS unsigned char* Vb = lds + AT_V0 + bf * AT_VB + vlane;
#pragma unroll
                for (int kk = 0; kk < 4; ++kk) {
                    v4u pw; pw.x = pk[4 * kk + 0]; pw.y = pk[4 * kk + 1]; pw.z = pk[4 * kk + 2]; pw.w = pk[4 * kk + 3];
                    const bf16x8 pb = __builtin_bit_cast(bf16x8, pw);
#pragma unroll
                    for (int db = 0; db < 4; ++db) {
                        const s16x4 lo = at_vtr(Vb + (16 * kk) * AT_VSTR + 64 * db), hi4 = at_vtr(Vb + (16 * kk + 8) * AT_VSTR + 64 * db);
                        bf16x8 va; va[0] = lo[0]; va[1] = lo[1]; va[2] = lo[2]; va[3] = lo[3]; va[4] = hi4[0]; va[5] = hi4[1]; va[6] = hi4[2]; va[7] = hi4[3];
                        o[db] = __builtin_amdgcn_mfma_f32_32x32x16_bf16(va, pb, o[db], 0, 0, 0);
                    }
                }
            }
              if (idx + 1 < ntiles) AT_WRITE_(idx + 1, AT_SET_T);
              AT_BAR(); }
        }
        __syncthreads();
#undef AT_ISSUE
#undef AT_WRITE
        const float ltot = lrow + __shfl_xor(lrow, 32);
        const float inv = 1.f / ltot;
        bf16* op = MIX + (size_t)(b * SEQ + tw + q32) * DM + (moba ? 0 : 2048) + h * 128 + 4 * hi;
#pragma unroll
        for (int db = 0; db < 4; ++db)
#pragma unroll
            for (int g = 0; g < 4; ++g) { v2u w; w.x = pk2(o[db][4 * g + 0] * inv, o[db][4 * g + 1] * inv); w.y = pk2(o[db][4 * g + 2] * inv, o[db][4 * g + 3] * inv);
                *(v2u*)(op + 32 * db + 8 * g) = w; }
      }
    }
}

__device__ __forceinline__ void ph_requant_mix(const Args& a, int lane, int wave, int G) {
    const bf16* MIX = (const bf16*)(a.ws + WS_MIX); unsigned char* MIXQ = a.ws + WS_MIXQ; float* MSC = (float*)(a.ws + WS_MSC); const float* sko = (const float*)(a.ws + WS_SKOF);
    const int gw = blockIdx.x * NWAVES + wave, NGW = G * NWAVES;
    for (int m = gw; m < NTOK; m += NGW) {
        const v4u* src = (const v4u*)(MIX + (size_t)m * DM) + lane;
        float f[8][8]; float mx = 0.f;
#pragma unroll
        for (int j = 0; j < 8; ++j) { const v4u w = src[64 * j]; const f32x4 s0 = *(const f32x4*)(sko + 8 * lane + 512 * j), s1 = *(const f32x4*)(sko + 8 * lane + 512 * j + 4);
            f[j][0] = bf_lo(w.x) * s0.x; f[j][1] = bf_hi(w.x) * s0.y; f[j][2] = bf_lo(w.y) * s0.z; f[j][3] = bf_hi(w.y) * s0.w;
            f[j][4] = bf_lo(w.z) * s1.x; f[j][5] = bf_hi(w.z) * s1.y; f[j][6] = bf_lo(w.w) * s1.z; f[j][7] = bf_hi(w.w) * s1.w;
#pragma unroll
            for (int e = 0; e < 8; ++e) mx = fmaxf(mx, fabsf(f[j][e])); }
#pragma unroll
        for (int o = 1; o < 64; o <<= 1) mx = fmaxf(mx, __shfl_xor(mx, o));
        const float qs = mx > 0.f ? mx * (1.f / 127.f) : 1.f, qi = 1.f / qs;
        if (lane == 0) MSC[m] = qs;
        v2u* dst = (v2u*)(MIXQ + (size_t)m * DM) + lane;
#pragma unroll
        for (int j = 0; j < 8; ++j) { int q[8];
#pragma unroll
            for (int e = 0; e < 8; ++e) q[e] = __float2int_rn(f[j][e] * qi);
            v2u o; o.x = ((unsigned)q[0] & 255u) | (((unsigned)q[1] & 255u) << 8) | (((unsigned)q[2] & 255u) << 16) | (((unsigned)q[3] & 255u) << 24);
            o.y = ((unsigned)q[4] & 255u) | (((unsigned)q[5] & 255u) << 8) | (((unsigned)q[6] & 255u) << 16) | (((unsigned)q[7] & 255u) << 24);
            dst[64 * j] = o; }
    }
}

__device__ __forceinline__ void ph8_select(const Args& a, LAS unsigned char* lds, int tid, int lane, int wave, int G) {
    const bf16* QP = (const bf16*)(a.ws + WS_QP); const bf16* SKB = (const bf16*)(a.ws + WS_SKB);
    int* EIDX = (int*)(a.ws + WS_EIDX); float* GATE = (float*)(a.ws + WS_GATE);
    LAS float* sc = (LAS float*)(lds + wave * 18944);
    LAS int* lst = (LAS int*)(lds + wave * 18944 + 16896);
    const int h = wave;
    const float* Vf = a.in[16]; float* vscp = (float*)(a.ws + WS_VSC);
    f32x4 cv[16];
#define P8_VISSUE(e_) do { const f32x4* sp_ = (const f32x4*)(Vf + (size_t)(e_) * DM) + lane; _Pragma("unroll") for (int j_ = 0; j_ < 16; ++j_) cv[j_] = sp_[64 * j_]; asm volatile("" ::: "memory"); } while (0)
#define P8_VFINISH(e_) do { float mx_ = 0.f; \
        _Pragma("unroll") for (int j_ = 0; j_ < 16; ++j_) mx_ = fmaxf(mx_, fmaxf(fmaxf(fabsf(cv[j_].x), fabsf(cv[j_].y)), fmaxf(fabsf(cv[j_].z), fabsf(cv[j_].w)))); \
        _Pragma("unroll") for (int o_ = 1; o_ < 64; o_ <<= 1) mx_ = fmaxf(mx_, __shfl_xor(mx_, o_)); \
        const float sc_ = mx_ > 0.f ? mx_ * (1.f / 127.f) : 1.f, inv_ = 1.f / sc_; \
        if (lane == 0) vscp[(e_)] = sc_; \
        unsigned char* dst_ = a.ws + WS_VB + (size_t)(e_) * 128 + ((4 * lane) & 127); \
        _Pragma("unroll") for (int j_ = 0; j_ < 16; ++j_) { \
            const int q0_ = __float2int_rn(cv[j_].x * inv_), q1_ = __float2int_rn(cv[j_].y * inv_), q2_ = __float2int_rn(cv[j_].z * inv_), q3_ = __float2int_rn(cv[j_].w * inv_); \
            *(unsigned*)(dst_ + (size_t)(2 * j_ + (lane >> 5)) * (16384 * 128)) = ((unsigned)q0_ & 255u) | (((unsigned)q1_ & 255u) << 8) | (((unsigned)q2_ & 255u) << 16) | (((unsigned)q3_ & 255u) << 24); } } while (0)
    for (int it = blockIdx.x; it < NTOK / 16; it += G) {
        const int t0 = it * 16; const int ev0 = 4 * (8 * it + wave);
        P8_VISSUE(ev0);
#pragma unroll
        for (int c = 0; c < 2; ++c) {
            bf16x8 A[4];
#pragma unroll
            for (int ks = 0; ks < 4; ++ks) A[ks] = *(const bf16x8*)(QP + (size_t)(t0 + (lane & 15)) * PQ + h * 256 + c * 128 + ks * 32 + (lane >> 4) * 8);
#pragma unroll
            for (int ng = 0; ng < 2; ++ng) {
                bf16x8 Bf[4][4];
#pragma unroll
                for (int n4 = 0; n4 < 4; ++n4)
#pragma unroll
                    for (int ks = 0; ks < 4; ++ks) Bf[n4][ks] = *(const bf16x8*)(SKB + (size_t)((h * 2 + c) * 128 + (4 * ng + n4) * 16 + (lane & 15)) * 128 + ks * 32 + (lane >> 4) * 8);
#pragma unroll
                for (int n4 = 0; n4 < 4; ++n4) { const int nt = 4 * ng + n4; f32x4 acc = {0.f, 0.f, 0.f, 0.f};
#pragma unroll
                    for (int ks = 0; ks < 4; ++ks) acc = __builtin_amdgcn_mfma_f32_16x16x32_bf16(Bf[n4][ks], A[ks], acc, 0, 0, 0);
                    *(LAS f32x4*)(sc + (c * 16 + (lane & 15)) * 132 + nt * 16 + (lane >> 4) * 4) = acc; }
            }
        }
        P8_VFINISH(ev0); P8_VISSUE(ev0 + 1);
        LDS_WAIT();
        {
            const int row = lane & 31, hh = lane >> 5;
            int L[16];
#pragma unroll
            for (int k = 0; k < 16; ++k) L[k] = (int)0x80000000;
            const LAS f32x4* rp = (const LAS f32x4*)(sc + row * 132 + 64 * hh);
            for (int i = 0; i < 16; ++i) {
                const f32x4 v = rp[i];
#pragma unroll
                for (int e = 0; e < 4; ++e) { int x = tokey((__float_as_uint(v[e]) & ~127u) | (unsigned)(64 * hh + i * 4 + e));
#pragma unroll
                    for (int k = 0; k < 16; ++k) { const int hi = max(L[k], x); x = min(L[k], x); L[k] = hi; } }
            }
            if (hh == 1) {
#pragma unroll
                for (int k = 0; k < 16; ++k) lst[row * 16 + k] = L[k];
            }
            P8_VFINISH(ev0 + 1); P8_VISSUE(ev0 + 2);
            LDS_WAIT();
            if (hh == 0) {
#pragma unroll
                for (int q = 0; q < 16; ++q) { int x = lst[row * 16 + q];
#pragma unroll
                    for (int k = 0; k < 16; ++k) { const int hi = max(L[k], x); x = min(L[k], x); L[k] = hi; } }
            }
            LDS_WAIT();
            if (hh == 0) {
#pragma unroll
                for (int k = 0; k < 16; ++k) lst[row * 16 + k] = L[k];
            }
        }
        P8_VFINISH(ev0 + 2); P8_VISSUE(ev0 + 3);
        LDS_WAIT();
        if (lane < 16) {
            float va[16], vb[16];
#pragma unroll
            for (int i = 0; i < 16; ++i) { const unsigned ia = unkey(lst[lane * 16 + i]) & 127u, ib = unkey(lst[(16 + lane) * 16 + i]) & 127u;
                va[i] = sc[lane * 132 + ia]; vb[i] = sc[(16 + lane) * 132 + ib]; }
            int L2[16];
#pragma unroll
            for (int k = 0; k < 16; ++k) L2[k] = (int)0x80000000;
#pragma unroll
            for (int i = 0; i < 16; ++i)
#pragma unroll
                for (int j = 0; j < 16; ++j)
                    if ((i + 1) * (j + 1) <= 16) { int x = tokey((__float_as_uint(va[i] + vb[j]) & ~255u) | (unsigned)(i * 16 + j));
#pragma unroll
                        for (int k = 0; k < 16; ++k) { const int hi = max(L2[k], x); x = min(L2[k], x); L2[k] = hi; } }
            float sv[16]; int ev[16]; float mxv = -3e38f;
#pragma unroll
            for (int k = 0; k < 16; ++k) { const unsigned code = unkey(L2[k]) & 255u; const int i = code >> 4, j = code & 15;
                const unsigned ea = unkey(lst[lane * 16 + i]) & 127u, eb = unkey(lst[(16 + lane) * 16 + j]) & 127u;
                const float s = sc[lane * 132 + ea] + sc[(16 + lane) * 132 + eb]; sv[k] = s; ev[k] = (int)(ea * 128u + eb); mxv = fmaxf(mxv, s); }
            float sum = 0.f;
#pragma unroll
            for (int k = 0; k < 16; ++k) { sv[k] = __expf(sv[k] - mxv); sum += sv[k]; }
            const float inv = 1.f / sum;
            int* ep = EIDX + (size_t)(t0 + lane) * 128 + h * 16; float* gp = GATE + (size_t)(t0 + lane) * 128 + h * 16;
#pragma unroll
            for (int k = 0; k < 16; ++k) { ep[k] = ev[k]; gp[k] = sv[k] * inv; }
        }
        P8_VFINISH(ev0 + 3);
        LDS_WAIT();
    }
#undef P8_VISSUE
#undef P8_VFINISH
}

__device__ __forceinline__ float gelu_exact(float x) { return 0.5f * x * (1.f + erff(x * 0.70710678118654752f)); }
__device__ __forceinline__ float ub0(unsigned x) { return (float)(x & 255u); }
__device__ __forceinline__ float ub1(unsigned x) { return (float)((x >> 8) & 255u); }
__device__ __forceinline__ float ub2(unsigned x) { return (float)((x >> 16) & 255u); }
__device__ __forceinline__ float ub3(unsigned x) { return (float)(x >> 24); }
template <int CTRL> __device__ __forceinline__ int dpp_i(int v) { return __builtin_amdgcn_update_dpp(0, v, CTRL, 0xf, 0xf, false); }
__device__ __forceinline__ void ph9_gather(const Args& a, LAS unsigned char* lds, int lane, int wave, int G) {
    const unsigned char* H2Q = a.ws + WS_H2Q; const float* HSC = (const float*)(a.ws + WS_HSC); const float* USC = (const float*)(a.ws + WS_USC); const float* VSC = (const float*)(a.ws + WS_VSC);
    const int* EIDX = (const int*)(a.ws + WS_EIDX); const float* GATE = (const float*)(a.ws + WS_GATE);
    const unsigned char* UB = a.ws + WS_UB; const unsigned char* VB = a.ws + WS_VB; const float* mod = (const float*)(a.ws + WS_MOD);
    const int p = lane >> 3, s = lane & 7; const unsigned s16 = (unsigned)s * 16u;
    LAS unsigned* offl = (LAS unsigned*)(lds + wave * 4096) + p * 16;
    LAS float* wl = (LAS float*)(lds + wave * 4096 + 2048) + p;
    const __amdgpu_buffer_rsrc_t rsu = __builtin_amdgcn_make_buffer_rsrc((void*)UB, (short)0, 32 * 16384 * 128, 0x00020000);
    const __amdgpu_buffer_rsrc_t rsv = __builtin_amdgcn_make_buffer_rsrc((void*)VB, (short)0, 32 * 16384 * 128, 0x00020000);
    for (int tg = blockIdx.x; tg < NTOK / 32; tg += G) {
        const int tb = tg * 32 + wave * 4, b = tb / SEQ;
        if (s == 0) { int pl = p; asm volatile("" : "+v"(pl));
#pragma unroll
            for (int tk = 0; tk < 4; ++tk)
#pragma unroll
                for (int i = 0; i < 16; ++i) offl[tk * 128 + i] = (unsigned)EIDX[(size_t)(tb + tk) * 128 + 8 * i + pl] * 128u;
        }
        LDS_WAIT();
        int acc[4][16];
#pragma unroll
        for (int tk = 0; tk < 4; ++tk)
#pragma unroll
            for (int i = 0; i < 16; ++i) acc[tk][i] = 0;
#ifndef P9_DUPU
#define P9_DUPU 1
#endif
#ifndef P9_DUPV
#define P9_DUPV 1
#endif
        { v4u uA[16], uB[16], hA, hB;
#define P9_ULOAD(R, HPV, c_, tk_) do { HPV = *(const v4u*)(H2Q + (size_t)(tb + (tk_)) * DM + (c_) * 128 + s * 16); \
            _Pragma("unroll") for (int i_ = 0; i_ < 16; ++i_) R[i_] = __builtin_amdgcn_raw_buffer_load_b128(rsu, (int)(offl[(tk_) * 128 + i_] + s16), (c_) * (16384 * 128), 0); } while (0)
#define P9_UDOT(R, HPV, tk_) do { _Pragma("unroll") for (int i_ = 0; i_ < 16; ++i_) { int d = acc[tk_][i_]; \
                d = __builtin_amdgcn_sdot4((int)R[i_].x, (int)HPV.x, d, false); d = __builtin_amdgcn_sdot4((int)R[i_].y, (int)HPV.y, d, false); \
                d = __builtin_amdgcn_sdot4((int)R[i_].z, (int)HPV.z, d, false); d = __builtin_amdgcn_sdot4((int)R[i_].w, (int)HPV.w, d, false); acc[tk_][i_] = d; } \
            asm volatile("" : "+v"(acc[tk_][0]), "+v"(acc[tk_][1]), "+v"(acc[tk_][2]), "+v"(acc[tk_][3]), "+v"(acc[tk_][4]), "+v"(acc[tk_][5]), "+v"(acc[tk_][6]), "+v"(acc[tk_][7]), \
                "+v"(acc[tk_][8]), "+v"(acc[tk_][9]), "+v"(acc[tk_][10]), "+v"(acc[tk_][11]), "+v"(acc[tk_][12]), "+v"(acc[tk_][13]), "+v"(acc[tk_][14]), "+v"(acc[tk_][15]) :: "memory"); } while (0)
          P9_ULOAD(uA, hA, 0, 0);
          for (int cc = 0; cc < 32 * P9_DUPU; ++cc) { const int c = cc & 31, cn = (cc + 1) & 31;
            P9_ULOAD(uB, hB, c, 1); P9_UDOT(uA, hA, 0);
            P9_ULOAD(uA, hA, c, 2); P9_UDOT(uB, hB, 1);
            P9_ULOAD(uB, hB, c, 3); P9_UDOT(uA, hA, 2);
            if (cc + 1 < 32 * P9_DUPU) P9_ULOAD(uA, hA, cn, 0);
            P9_UDOT(uB, hB, 3);
          }
#undef P9_ULOAD
#undef P9_UDOT
        }
        LAS unsigned* whl = (LAS unsigned*)(lds + wave * 4096 + 2048) + p * 8;
        float wsc[4];
#pragma unroll
        for (int tk = 0; tk < 4; ++tk) {
            const float hs = HSC[tb + tk]; float wmx = 0.f; float wv[16]; int pg = p; asm volatile("" : "+v"(pg));
#pragma unroll
            for (int i = 0; i < 16; i += 2) { int d0 = acc[tk][i], d1 = acc[tk][i + 1];
                d0 /= P9_DUPU; d1 /= P9_DUPU;
                d0 += dpp_i<0xB1>(d0); d0 += dpp_i<0x4E>(d0); d0 += dpp_i<0x141>(d0);
                d1 += dpp_i<0xB1>(d1); d1 += dpp_i<0x4E>(d1); d1 += dpp_i<0x141>(d1);
                const unsigned e0 = offl[tk * 128 + i] >> 7, e1 = offl[tk * 128 + i + 1] >> 7;
                const pg8::f32x2 gl = pg8::gelu_pk((pg8::f32x2){(float)d0 * (USC[e0] * hs), (float)d1 * (USC[e1] * hs)});
                const float w0 = GATE[(size_t)(tb + tk) * 128 + 8 * i + pg] * gl.x * VSC[e0], w1 = GATE[(size_t)(tb + tk) * 128 + 8 * (i + 1) + pg] * gl.y * VSC[e1];
                wv[i] = w0; wv[i + 1] = w1; wmx = fmaxf(wmx, fmaxf(fabsf(w0), fabsf(w1))); }
            wmx = fmaxf(wmx, __shfl_xor(wmx, 8)); wmx = fmaxf(wmx, __shfl_xor(wmx, 16)); wmx = fmaxf(wmx, __shfl_xor(wmx, 32));
            const float wsv = wmx > 1e-30f ? wmx : 1.f, qf = 16256.f / wsv; wsc[tk] = wsv * (1.f / 16256.f);
#pragma unroll
            for (int g = 0; g < 4; ++g) { unsigned ph = 0u, pl = 0u;
#pragma unroll
                for (int q = 0; q < 4; ++q) { const int W = __float2int_rn(wv[4 * g + q] * qf); const int hi = (W + 64) >> 7, lo = W - (hi << 7);
                    ph |= ((unsigned)hi & 255u) << (8 * q); pl |= ((unsigned)lo & 255u) << (8 * q); }
                if (s == 0) { whl[tk * 64 + g * 2] = ph; whl[tk * 64 + g * 2 + 1] = pl; } }
            asm volatile("" ::: "memory"); }
        LDS_WAIT();
        const float* g2 = mod + (size_t)b * NMOD + 5 * DM;
        LAS float* g2l = (LAS float*)(lds + 32768);
        __syncthreads();
        { const f32x4 t0 = *(const f32x4*)(g2 + 4 * (wave * 64 + lane)), t1 = *(const f32x4*)(g2 + 2048 + 4 * (wave * 64 + lane));
          *(LAS f32x4*)(g2l + 4 * (wave * 64 + lane)) = t0; *(LAS f32x4*)(g2l + 2048 + 4 * (wave * 64 + lane)) = t1; }
        __syncthreads();
        v4u rA[16], rB[16]; v4u xA, xB;
#define P9_VLOAD(R, X, c_, tk_) do { \
            X = (v4u){0u, 0u, 0u, 0u}; \
            if (p < 2) { int lo_ = s * 16 + 8 * p; asm volatile("" : "+v"(lo_)); X = *(const v4u*)((const bf16*)(a.ws + WS_H) + (size_t)(tb + (tk_)) * DM + (c_) * 128 + lo_); } \
            _Pragma("unroll") for (int i_ = 0; i_ < 16; ++i_) R[i_] = __builtin_amdgcn_raw_buffer_load_b128(rsv, (int)(offl[(tk_) * 128 + i_] + s16), (c_) * (16384 * 128), 0); } while (0)
#define P9_OUT(X, c_, tk_) do { int so_ = s * 16 + 8 * p; asm volatile("" : "+v"(so_)); float* op = a.out + (size_t)(tb + (tk_)) * DM + (c_) * 128 + so_; \
            const f32x4 ya = {y[0], y[1], y[2], y[3]}, yb = {y[4], y[5], y[6], y[7]}; \
            const f32x4 ga_ = *(const LAS f32x4*)(g2l + (c_) * 128 + so_), gb_ = *(const LAS f32x4*)(g2l + (c_) * 128 + so_ + 4); \
            const f32x4 x0_ = {bf_lo(X.x), bf_hi(X.x), bf_lo(X.y), bf_hi(X.y)}, x1_ = {bf_lo(X.z), bf_hi(X.z), bf_lo(X.w), bf_hi(X.w)}; \
            *(f32x4*)op = x0_ + ga_ * ya; *(f32x4*)(op + 4) = x1_ + gb_ * yb; } while (0)
#define P9_VPROC(R, X, c_, tk_) do { int yh[16], yl[16]; \
            _Pragma("unroll") for (int j = 0; j < 16; ++j) { yh[j] = 0; yl[j] = 0; } \
            _Pragma("unroll") for (int g = 0; g < 4; ++g) { const int wh_ = (int)whl[(tk_) * 64 + g * 2], wl_ = (int)whl[(tk_) * 64 + g * 2 + 1]; \
                _Pragma("unroll") for (int dw = 0; dw < 4; ++dw) { const unsigned a_ = R[4 * g][dw], b_ = R[4 * g + 1][dw], c2_ = R[4 * g + 2][dw], d_ = R[4 * g + 3][dw]; \
                    const unsigned t0 = __builtin_amdgcn_perm(b_, a_, 0x05010400u), t1 = __builtin_amdgcn_perm(b_, a_, 0x07030602u), t2 = __builtin_amdgcn_perm(d_, c2_, 0x05010400u), t3 = __builtin_amdgcn_perm(d_, c2_, 0x07030602u); \
                    const int o0 = (int)__builtin_amdgcn_perm(t2, t0, 0x05040100u), o1 = (int)__builtin_amdgcn_perm(t2, t0, 0x07060302u), o2 = (int)__builtin_amdgcn_perm(t3, t1, 0x05040100u), o3 = (int)__builtin_amdgcn_perm(t3, t1, 0x07060302u); \
                    yh[4 * dw + 0] = __builtin_amdgcn_sdot4(o0, wh_, yh[4 * dw + 0], false); yl[4 * dw + 0] = __builtin_amdgcn_sdot4(o0, wl_, yl[4 * dw + 0], false); \
                    yh[4 * dw + 1] = __builtin_amdgcn_sdot4(o1, wh_, yh[4 * dw + 1], false); yl[4 * dw + 1] = __builtin_amdgcn_sdot4(o1, wl_, yl[4 * dw + 1], false); \
                    yh[4 * dw + 2] = __builtin_amdgcn_sdot4(o2, wh_, yh[4 * dw + 2], false); yl[4 * dw + 2] = __builtin_amdgcn_sdot4(o2, wl_, yl[4 * dw + 2], false); \
                    yh[4 * dw + 3] = __builtin_amdgcn_sdot4(o3, wh_, yh[4 * dw + 3], false); yl[4 * dw + 3] = __builtin_amdgcn_sdot4(o3, wl_, yl[4 * dw + 3], false); } } \
            float y[16]; \
            _Pragma("unroll") for (int j = 0; j < 16; ++j) y[j] = (float)(yh[j] * 128 + yl[j]) * wsc[tk_]; \
            _Pragma("unroll") for (int j = 0; j < 16; ++j) y[j] += dpp_f<0x128, 0xf>(y[j]);            \
            _Pragma("unroll") for (int k = 0; k < 8; ++k) { float lo_ = y[k], hi_ = y[8 + k]; asm volatile("" : "+v"(lo_), "+v"(hi_));     \
                y[k] = (p & 1) ? hi_ : lo_;            \
                y[k] += __shfl_xor(y[k], 16); y[k] += __shfl_xor(y[k], 32); } \
            if (wr_ && p < 2) P9_OUT(X, c_, tk_); \
            asm volatile("" ::: "memory"); } while (0)
        P9_VLOAD(rA, xA, 0, 0);
        for (int cc = 0; cc < 32 * P9_DUPV; ++cc) { const int c = cc & 31, cn = (cc + 1) & 31; const bool wr_ = (cc >= 32 * (P9_DUPV - 1)) || (wsc[0] == 12345.678f);
            P9_VLOAD(rB, xB, c, 1); P9_VPROC(rA, xA, c, 0);
            P9_VLOAD(rA, xA, c, 2); P9_VPROC(rB, xB, c, 1);
            P9_VLOAD(rB, xB, c, 3); P9_VPROC(rA, xA, c, 2);
            if (cc + 1 < 32 * P9_DUPV) P9_VLOAD(rA, xA, cn, 0);
            P9_VPROC(rB, xB, c, 3);
        }
#undef P9_VLOAD
#undef P9_VPROC
#undef P9_OUT
        LDS_WAIT();
    }
}

__device__ __forceinline__ void transpose_item_i8w(const float* W, int ld, int K, unsigned char* WQ, const float* skinv, LAS float* scr, int kb, int n0, int lane) {
    const int k0 = 128 * kb;
    float tv[64];
#pragma unroll
    for (int i = 0; i < 64; ++i) tv[i] = W[(size_t)(k0 + 2 * i + (lane >> 5)) * ld + n0 + (lane & 31)];
#pragma unroll
    for (int i = 0; i < 64; ++i) scr[(2 * i + (lane >> 5)) * 33 + (lane & 31)] = tv[i];
    const int c = lane & 7, nl = lane >> 3;
    float si[16];
#pragma unroll
    for (int q = 0; q < 4; ++q) { const f32x4 t = *(const f32x4*)(skinv + k0 + 16 * c + 4 * q); si[4 * q] = t.x; si[4 * q + 1] = t.y; si[4 * q + 2] = t.z; si[4 * q + 3] = t.w; }
    LDS_WAIT();
#pragma unroll
    for (int jj = 0; jj < 4; ++jj) { const int n = nl + 8 * jj; const LAS float* sp = scr + (16 * c) * 33 + n; v4u o;
#pragma unroll
        for (int q = 0; q < 4; ++q) { const int q0 = __float2int_rn(sp[(4 * q) * 33] * si[4 * q]), q1 = __float2int_rn(sp[(4 * q + 1) * 33] * si[4 * q + 1]), q2 = __float2int_rn(sp[(4 * q + 2) * 33] * si[4 * q + 2]), q3 = __float2int_rn(sp[(4 * q + 3) * 33] * si[4 * q + 3]);
            o[q] = ((unsigned)q0 & 255u) | (((unsigned)q1 & 255u) << 8) | (((unsigned)q2 & 255u) << 16) | (((unsigned)q3 & 255u) << 24); }
        *(v4u*)(WQ + (size_t)(n0 + n) * K + k0 + 16 * c) = o; }
    LDS_WAIT();
}
__device__ __forceinline__ void transpose_item_i8n(const float* W, int ld, int K, unsigned char* WQ, const unsigned* colmax_bits, LAS float* scr, int kb, int n0, int lane) {
    const int k0 = 64 * kb;
    float tv[32];
#pragma unroll
    for (int i = 0; i < 32; ++i) tv[i] = W[(size_t)(k0 + 2 * i + (lane >> 5)) * ld + n0 + (lane & 31)];
#pragma unroll
    for (int i = 0; i < 32; ++i) scr[(2 * i + (lane >> 5)) * 33 + (lane & 31)] = tv[i];
    const int c = lane & 3, nl = lane >> 2;
    LDS_WAIT();
#pragma unroll
    for (int jj = 0; jj < 2; ++jj) { const int n = nl + 16 * jj; const LAS float* sp = scr + (16 * c) * 33 + n; v4u o;
        const float mxv = __uint_as_float(colmax_bits[n0 + n]); const float si = mxv > 0.f ? 127.f / mxv : 1.f;
#pragma unroll
        for (int q = 0; q < 4; ++q) { const int q0 = __float2int_rn(sp[(4 * q) * 33] * si), q1 = __float2int_rn(sp[(4 * q + 1) * 33] * si), q2 = __float2int_rn(sp[(4 * q + 2) * 33] * si), q3 = __float2int_rn(sp[(4 * q + 3) * 33] * si);
            o[q] = ((unsigned)q0 & 255u) | (((unsigned)q1 & 255u) << 8) | (((unsigned)q2 & 255u) << 16) | (((unsigned)q3 & 255u) << 24); }
        *(v4u*)(WQ + (size_t)(n0 + n) * K + k0 + 16 * c) = o; }
    LDS_WAIT();
}
__device__ __forceinline__ void transpose_item_q8(const unsigned char* Wq, int ld, int K, unsigned char* WQ, LAS unsigned char* scr, int kb, int nb, int lane) {
    const int k0 = 128 * kb, n0 = 128 * nb;
    v4u tv[16];
#pragma unroll
    for (int i = 0; i < 16; ++i) tv[i] = *(const v4u*)(Wq + (size_t)(k0 + 8 * i + (lane >> 3)) * ld + n0 + 16 * (lane & 7));
#pragma unroll
    for (int i = 0; i < 16; ++i) { LAS unsigned* d = (LAS unsigned*)(scr + (8 * i + (lane >> 3)) * 132 + 16 * (lane & 7)); d[0] = tv[i].x; d[1] = tv[i].y; d[2] = tv[i].z; d[3] = tv[i].w; }
    LDS_WAIT();
    const int kc = lane & 7, nl = lane >> 3;
#pragma unroll
    for (int jj = 0; jj < 16; ++jj) { const int n = nl + 8 * jj; const LAS unsigned char* sp = scr + (16 * kc) * 132 + n; v4u o;
#pragma unroll
        for (int q = 0; q < 4; ++q) o[q] = (unsigned)sp[(4 * q) * 132] | ((unsigned)sp[(4 * q + 1) * 132] << 8) | ((unsigned)sp[(4 * q + 2) * 132] << 16) | ((unsigned)sp[(4 * q + 3) * 132] << 24);
        *(v4u*)(WQ + (size_t)(n0 + n) * K + k0 + 16 * kc) = o; }
    LDS_WAIT();
}
__device__ __forceinline__ void p1_transpose_win(const Args& a, LAS unsigned char* lds, int lane, int wave, int G) {
    const int gw = blockIdx.x * NWAVES + wave, NGW = G * NWAVES;
    LAS unsigned char* scr = lds + wave * 16896;
    for (int it = gw; it < 3072 + 1024 + 4096; it += NGW) {
        if (it < 3072) transpose_item_q8(a.ws + WS_WINKN, NQKV, DM, a.ws + WS_WINQ, scr, it / 96, it % 96, lane);
        else if (it < 4096) { const int r = it - 3072; transpose_item_q8(a.ws + WS_WOKN, DM, DM, a.ws + WS_WOQ, scr, r / 32, r % 32, lane); }
        else { const int r = it - 4096; transpose_item_i8n(a.in[13], PQ, DM, a.ws + WS_WPQQ, (const unsigned*)(a.ws + WS_PQMAX), (LAS float*)scr, r / 64, 32 * (r % 64), lane); }
    }
    __syncthreads();
}

#ifndef MK_ONE_LAUNCH
#define MK_ONE_LAUNCH 1
#endif
__global__ void __launch_bounds__(NTHR, 2) hymba_fwd(Args a) {
    extern __shared__ __attribute__((aligned(16))) unsigned char lds_raw[];
    LAS unsigned char* lds = (LAS unsigned char*)lds_raw;
    const int tid = threadIdx.x, lane = tid & 63, wave = __builtin_amdgcn_readfirstlane(tid >> 6), G = gridDim.x;
    volatile LAS unsigned* MISC = (volatile LAS unsigned*)(lds + MISC_OFF);
    if (tid < 64) MISC[tid] = 0u;
    __syncthreads();
    const int lo = a.ph_lo, hi = a.ph_hi;
    XcdBarrier bar; bar.bar = (unsigned*)(a.ws + WS_CTL) + CW_BAR; bar.x = 0; bar.st = nullptr;
    if (hi - lo > 1) bar = xcd_barrier_post((unsigned*)(a.ws + WS_CTL) + CW_BAR, MISC + 8);
#define IN(k) (lo <= (k) && (k) < hi)
#define SEAM(k) do { if (IN(k) && IN((k) + 1)) xcd_barrier(bar); } while (0)
    float* mod = (float*)(a.ws + WS_MOD);
    bf16* H = (bf16*)(a.ws + WS_H);

#ifndef DUP_MASK
#define DUP_MASK 0
#endif
#define RUN(k, ...) do { if (IN(k)) { __VA_ARGS__; if ((DUP_MASK >> (k)) & 1) { xcd_barrier(bar); __VA_ARGS__; } SEAM(k); } } while (0)
    RUN(0, ph0_prologue(a, lds, tid, lane, wave, G));
#ifndef P1_DUPT
#define P1_DUPT 0
#endif
#ifndef P1_DUPN
#define P1_DUPN 0
#endif
    RUN(1, { p1_transpose_win(a, lds, lane, wave, G); if (P1_DUPT) p1_transpose_win(a, lds, lane, wave, G);
        if (P1_DUPN) ph_norm<true>(a.in[0], a.in[4], mod + 0 * DM, mod + 1 * DM, H, a.ws + WS_H1Q, (float*)(a.ws + WS_HSC1), (const float*)(a.ws + WS_SKF), (const float*)(a.ws + WS_FGIMG), a.in[6], (float*)(a.ws + WS_LOGF), lds, lane, wave, G);
        ph_norm<true>(a.in[0], a.in[4], mod + 0 * DM, mod + 1 * DM, H, a.ws + WS_H1Q, (float*)(a.ws + WS_HSC1), (const float*)(a.ws + WS_SKF), (const float*)(a.ws + WS_FGIMG), a.in[6], (float*)(a.ws + WS_LOGF), lds, lane, wave, G); });
    RUN(2, { fcum_items(a, lds, tid, lane, wave, G);
        { pg8::Gemm g{(const pg8::bf16_t*)(a.ws + WS_H1Q), (const pg8::bf16_t*)(a.ws + WS_WINQ), NTOK, NQKV, DM / 2}; pg8::StaticOrder S; S.init(NTOK, NQKV, G, (int)blockIdx.x);
          pg8::EpiInProj<true> E{(pg8::bf16_t*)(a.ws + WS_PROJ), NQKV, 0, (const float*)(a.ws + WS_HSC1), (const float*)(a.ws + WS_GT), (float*)(a.ws + WS_KMEAN), (LAS float*)(lds + 131072), EPS};
          pg8::gemm_phase<pg8::EpiInProj<true>, pg8::StaticOrder, true, true, true>(lds, g, S, E); } });
    RUN(3, ph4_attn_mfma(a, lds, tid, lane, wave, G));
    RUN(4, ph_requant_mix(a, lane, wave, G));
    RUN(5, { pg8::Gemm g{(const pg8::bf16_t*)(a.ws + WS_MIXQ), (const pg8::bf16_t*)(a.ws + WS_WOQ), NTOK, DM, DM / 2}; pg8::StaticOrder S; S.init(NTOK, DM, G, (int)blockIdx.x);
        pg8::EpiResGateBf<true> E{a.in[0], (pg8::bf16_t*)(a.ws + WS_H), DM, mod + 2 * DM, SEQ, NMOD, (const float*)(a.ws + WS_MSC)};
        pg8::gemm_phase<pg8::EpiResGateBf<true>, pg8::StaticOrder, true, true, true>(lds, g, S, E); });
    RUN(6, ph_norm<false, false, true>((const float*)(a.ws + WS_H), a.in[12], mod + 3 * DM, mod + 4 * DM, H, a.ws + WS_H2Q, (float*)(a.ws + WS_HSC), nullptr, nullptr, nullptr, nullptr, lds, lane, wave, G));
    RUN(7, { pg8::Gemm g{(const pg8::bf16_t*)(a.ws + WS_H2Q), (const pg8::bf16_t*)(a.ws + WS_WPQQ), NTOK, PQ, DM / 2}; pg8::StaticOrder S; S.init(NTOK, PQ, G, (int)blockIdx.x);
        pg8::EpiBf16RC E{(pg8::bf16_t*)(a.ws + WS_QP), PQ, (const float*)(a.ws + WS_HSC), (const unsigned*)(a.ws + WS_PQMAX)};
        pg8::gemm_phase<pg8::EpiBf16RC, pg8::StaticOrder, true, true, true>(lds, g, S, E); });
    RUN(8, ph8_select(a, lds, tid, lane, wave, G));
    RUN(9, ph9_gather(a, lds, lane, wave, G));
#undef RUN
#undef IN
#undef SEAM
}

extern "C" void kernel_launch(void* const* d_in, const int* in_sizes, int n_in, void* d_out, int out_size, void* d_ws, size_t ws_size, hipStream_t stream) {
    static int grid = 0;
    if (grid == 0) {
        if (n_in != 17 || out_size != NTOK * DM || ws_size < WS_END) { fprintf(stderr, "kernel_launch: unexpected shapes (n_in %d out %d ws %zu)\n", n_in, out_size, ws_size); grid = -1; return; }
        int dev = 0, cus = 0, per_cu = 0;
        if (hipGetDevice(&dev) != hipSuccess || hipDeviceGetAttribute(&cus, hipDeviceAttributeMultiprocessorCount, dev) != hipSuccess) { grid = -1; return; }
        if (hipFuncSetAttribute((const void*)hymba_fwd, hipFuncAttributeMaxDynamicSharedMemorySize, LDS_BYTES) != hipSuccess) { fprintf(stderr, "kernel_launch: hipFuncSetAttribute failed\n"); grid = -1; return; }
        if (hipOccupancyMaxActiveBlocksPerMultiprocessor(&per_cu, (const void*)hymba_fwd, NTHR, LDS_BYTES) != hipSuccess || per_cu < 1)
            fprintf(stderr, "kernel_launch: note: occupancy query reports %d workgroups per CU\n", per_cu);
        (void)hipGetLastError();
        grid = cus;
    }
    if (grid < 0) return;
    if (hipMemsetAsync((char*)d_ws + WS_CTL, 0, ZERO_BYTES, stream) != hipSuccess) { fprintf(stderr, "kernel_launch: memset failed\n"); return; }
    Args a{};
    for (int i = 0; i < 17; ++i) a.in[i] = (const float*)d_in[i];
    a.out = (float*)d_out; a.ws = (unsigned char*)d_ws;
#if MK_ONE_LAUNCH
    a.ph_lo = 0; a.ph_hi = NPH;
    hipLaunchKernelGGL(hymba_fwd, dim3(grid), dim3(NTHR), LDS_BYTES, stream, a);
#else
    for (int p = 0; p < NPH; ++p) { a.ph_lo = p; a.ph_hi = p + 1; hipLaunchKernelGGL(hymba_fwd, dim3(grid), dim3(NTHR), LDS_BYTES, stream, a); }
#endif
}
```
